# Optimizing an MI355X kernel written in HIP

```python
import math
import jax, jax.numpy as jnp
from jax import lax
import numpy as np


D_MODEL = 1024
BATCH = 16
SEQ = 2048
DEPTH = 4

D_ATTN = 512
ATTN_HEADS = 4
ATTN_QK_DIM = 64
ATTN_V_DIM = 128
Q_BLOCK = 128
REL_BUCKETS = 32
REL_MAX_DISTANCE = 128
SUBLN_EPS = 1e-5
D_HYENA = 512
HYENA_ORDER = 2
HYENA_SHORT_CONV = 3
N_DIRS = 2
FILTER_BANDS = 16
FILTER_EMB = 2 * FILTER_BANDS + 1
FILTER_WIDTH = 64
FAST_DECAY_PCT = 0.3
SLOW_DECAY_PCT = 1.5
DECAY_TARGET = 1e-2
NORM_EPS = 1e-6
FILTER_CH = N_DIRS * HYENA_ORDER * D_HYENA
W_IN_COLS = 4 * D_ATTN + 4 * D_HYENA + 2 * D_MODEL

kernel_name = "hybrid_diffattn_hyena_encoder"


def rms_norm(x, gain, eps):
    x32 = x.astype(jnp.float32)
    y = x32 * lax.rsqrt(jnp.mean(x32 * x32, axis=-1, keepdims=True) + eps)
    return (y * gain.astype(jnp.float32)).astype(x.dtype)


def t5_bucket(rel):
    nb = REL_BUCKETS // 2
    max_exact = nb // 2
    ret = jnp.where(rel > 0, nb, 0)
    n = jnp.abs(rel)
    nf = jnp.maximum(n, 1).astype(jnp.float32)
    large = max_exact + (jnp.log(nf / max_exact) / math.log(REL_MAX_DISTANCE / max_exact)
                         * (nb - max_exact)).astype(jnp.int32)
    large = jnp.minimum(large, nb - 1)
    return ret + jnp.where(n < max_exact, n, large)


def diff_attention(q, k, v, lam, rel_bias):
    B, S = q.shape[0], q.shape[1]
    nblk = S // Q_BLOCK
    qb = (q * (ATTN_QK_DIM ** -0.5)).reshape(B, nblk, Q_BLOCK, ATTN_HEADS, 2, ATTN_QK_DIM)
    qb = qb.transpose(1, 0, 3, 4, 2, 5)
    kt = k.transpose(0, 2, 3, 1, 4)
    vt = v.transpose(0, 2, 1, 3)
    k_pos = jnp.arange(S, dtype=jnp.int32)

    def block(args):
        q_blk, i = args
        q_pos = i * Q_BLOCK + jnp.arange(Q_BLOCK, dtype=jnp.int32)
        bucket = t5_bucket(k_pos[None, :] - q_pos[:, None])
        bias = rel_bias[bucket].astype(jnp.float32).transpose(2, 0, 1)
        logits = jnp.einsum('bhcqd,bhckd->bhcqk', q_blk, kt).astype(jnp.float32)
        p = jax.nn.softmax(logits + bias[None, :, None], axis=-1)
        w = p[:, :, 0] - lam * p[:, :, 1]
        return jnp.einsum('bhqk,bhkd->bhqd', w.astype(vt.dtype), vt)

    out = lax.map(block, (qb, jnp.arange(nblk, dtype=jnp.int32)))
    return out.transpose(1, 0, 3, 2, 4).reshape(B, S, ATTN_HEADS, ATTN_V_DIM)


def short_conv3(u, w, b):
    up = jnp.pad(u, ((0, 0), (1, 1), (0, 0)))
    return up[:, :-2] * w[0] + up[:, 1:-1] * w[1] + up[:, 2:] * w[2] + b


def hyena_filters(L, w1, b1, w2, b2, w3, b3, freq, w_out, deltas):
    t = jnp.linspace(0.0, 1.0, L, dtype=jnp.float32)[:, None]
    t_res = jnp.arange(L, dtype=jnp.float32)[:, None]
    f = jnp.linspace(1e-4, FILTER_BANDS - 1, FILTER_BANDS, dtype=jnp.float32)[None, :]
    ang = 2.0 * math.pi * t_res * f / L
    z = jnp.concatenate([t, jnp.cos(ang), -jnp.sin(ang)], axis=-1)
    a = jnp.sin(freq * (z @ w1 + b1))
    a = jnp.sin(freq * (a @ w2 + b2))
    a = jnp.sin(freq * (a @ w3 + b3))
    decay = jnp.exp(-t * jnp.abs(deltas)[None, :])
    h = ((a @ w_out) * decay).astype(jnp.float32).reshape(L, N_DIRS, HYENA_ORDER, D_HYENA)
    fwd, bwd = h[:, 0], h[:, 1]
    two_sided = jnp.concatenate(
        [fwd, jnp.zeros((1, HYENA_ORDER, D_HYENA), jnp.float32), bwd[:0:-1]], axis=0)
    return jnp.fft.rfft(two_sided, axis=0)


def fft_long_conv(u, h_f, bias):
    L = u.shape[1]
    u32 = u.astype(jnp.float32)
    y = jnp.fft.irfft(jnp.fft.rfft(u32, n=2 * L, axis=1) * h_f[None], n=2 * L, axis=1)[:, :L]
    return (y + u32 * bias.astype(jnp.float32)).astype(u.dtype)


def setup_inputs(seed: int = 0) -> dict:
    key = jax.random.key(seed)
    ks = jax.random.split(key, 26)

    def nrm(k, shape, s):
        return jax.random.normal(k, shape, jnp.float32) * s

    deltas0 = jnp.linspace(math.log(FAST_DECAY_PCT) / DECAY_TARGET,
                           math.log(SLOW_DECAY_PCT) / DECAY_TARGET, FILTER_CH, dtype=jnp.float32)
    return {
        "x": nrm(ks[0], (BATCH, SEQ, D_MODEL), 1.0),
        "rel_bias": nrm(ks[1], (REL_BUCKETS, ATTN_HEADS), 0.1),
        "pre_norm": 1.0 + nrm(ks[2], (DEPTH, D_MODEL), 0.02),
        "post_norm": 1.0 + nrm(ks[3], (DEPTH, D_MODEL), 0.02),
        "w_in": nrm(ks[4], (DEPTH, D_MODEL, W_IN_COLS), D_MODEL ** -0.5),
        "lam_q1": nrm(ks[5], (DEPTH, ATTN_QK_DIM), 0.1),
        "lam_k1": nrm(ks[6], (DEPTH, ATTN_QK_DIM), 0.1),
        "lam_q2": nrm(ks[7], (DEPTH, ATTN_QK_DIM), 0.1),
        "lam_k2": nrm(ks[8], (DEPTH, ATTN_QK_DIM), 0.1),
        "subln": 1.0 + nrm(ks[9], (DEPTH, ATTN_V_DIM), 0.02),
        "conv_w": nrm(ks[10], (DEPTH, HYENA_SHORT_CONV, 3 * D_HYENA), HYENA_SHORT_CONV ** -0.5),
        "conv_b": nrm(ks[11], (DEPTH, 3 * D_HYENA), 0.02),
        "flt_w1": nrm(ks[12], (DEPTH, FILTER_EMB, FILTER_WIDTH), FILTER_EMB ** -0.5),
        "flt_b1": nrm(ks[13], (DEPTH, FILTER_WIDTH), 0.1),
        "flt_w2": nrm(ks[14], (DEPTH, FILTER_WIDTH, FILTER_WIDTH), FILTER_WIDTH ** -0.5),
        "flt_b2": nrm(ks[15], (DEPTH, FILTER_WIDTH), 0.1),
        "flt_w3": nrm(ks[16], (DEPTH, FILTER_WIDTH, FILTER_WIDTH), FILTER_WIDTH ** -0.5),
        "flt_b3": nrm(ks[17], (DEPTH, FILTER_WIDTH), 0.1),
        "flt_freq": 1.0 + nrm(ks[18], (DEPTH, FILTER_WIDTH), 0.01),
        "flt_w_out": nrm(ks[19], (DEPTH, FILTER_WIDTH, FILTER_CH), 0.1 * FILTER_WIDTH ** -0.5),
        "flt_deltas": deltas0[None, :] + nrm(ks[20], (DEPTH, FILTER_CH), 0.01),
        "flt_bias": nrm(ks[21], (DEPTH, HYENA_ORDER, D_HYENA), 0.1),
        "w_pa": nrm(ks[22], (DEPTH, D_ATTN, D_MODEL), D_ATTN ** -0.5),
        "w_ph": nrm(ks[23], (DEPTH, D_HYENA, D_MODEL), D_HYENA ** -0.5),
        "w_out": nrm(ks[24], (DEPTH, D_MODEL, D_MODEL), D_MODEL ** -0.5),
    }


def reference(x, rel_bias, pre_norm, post_norm, w_in, lam_q1, lam_k1, lam_q2, lam_k2, subln,
              conv_w, conv_b, flt_w1, flt_b1, flt_w2, flt_b2, flt_w3, flt_b3, flt_freq,
              flt_w_out, flt_deltas, flt_bias, w_pa, w_ph, w_out):
    B, S, _ = x.shape
    widths = (D_ATTN, D_ATTN, D_ATTN, D_ATTN, 3 * D_HYENA, D_HYENA, D_MODEL, D_MODEL)
    splits = [int(c) for c in np.cumsum(widths)[:-1]]
    for l in range(DEPTH):
        lam_init = 0.8 - 0.6 * math.exp(-0.3 * l)
        h = rms_norm(x, pre_norm[l], NORM_EPS)
        proj = h @ w_in[l]
        q, k, v, z_a, u_h, z_h, g_a, g_h = jnp.split(proj, splits, axis=-1)

        lam = (jnp.exp(jnp.sum(lam_q1[l].astype(jnp.float32) * lam_k1[l].astype(jnp.float32)))
               - jnp.exp(jnp.sum(lam_q2[l].astype(jnp.float32) * lam_k2[l].astype(jnp.float32)))
               + lam_init)
        o = diff_attention(q.reshape(B, S, ATTN_HEADS, 2, ATTN_QK_DIM),
                           k.reshape(B, S, ATTN_HEADS, 2, ATTN_QK_DIM),
                           v.reshape(B, S, ATTN_HEADS, ATTN_V_DIM), lam, rel_bias)
        o = rms_norm(o, subln[l], SUBLN_EPS) * (1.0 - lam_init)
        y_a = o.reshape(B, S, D_ATTN) * jax.nn.silu(z_a)

        u_h = short_conv3(u_h, conv_w[l], conv_b[l])
        hv, hx1, hx2 = jnp.split(u_h, 3, axis=-1)
        filt = hyena_filters(S, flt_w1[l], flt_b1[l], flt_w2[l], flt_b2[l], flt_w3[l], flt_b3[l],
                             flt_freq[l], flt_w_out[l], flt_deltas[l])
        z = fft_long_conv(hv, filt[:, 0], flt_bias[l, 0]) * hx1
        z = fft_long_conv(z, filt[:, 1], flt_bias[l, 1]) * hx2
        y_h = z * jax.nn.silu(z_h)

        m = jax.nn.sigmoid(g_a) * (y_a @ w_pa[l]) + jax.nn.sigmoid(g_h) * (y_h @ w_ph[l])
        x = x + rms_norm(m @ w_out[l], post_norm[l], NORM_EPS)
    return x
```

```cpp
#include <hip/hip_runtime.h>
#include <cstdio>
#include <cstdint>

#define LAS __attribute__((address_space(3)))
typedef unsigned short bf16_t;
typedef short bf16x8 __attribute__((ext_vector_type(8)));
typedef float f32x4 __attribute__((ext_vector_type(4)));
typedef float f32x16 __attribute__((ext_vector_type(16)));
typedef unsigned u32x4 __attribute__((ext_vector_type(4)));
typedef unsigned u32x2 __attribute__((ext_vector_type(2)));

constexpr int DM = 1024, NBATCH = 16, SEQ = 2048, DEPTH = 4, MTOK = NBATCH * SEQ;
constexpr int WIN = 6144;
constexpr int NA1 = 3584;
constexpr int NA2 = 2560;
constexpr float QSCALE = 0.125f * 1.4426950408889634f;
constexpr float LOG2E = 1.4426950408889634f;
constexpr int NWAVES = 8, NTHR = 512;

constexpr size_t MiB = 1u << 20;
constexpr size_t WS_CTL = 0, CTL_ZERO_BYTES = 256 * 1024;
constexpr int PC_WORD0 = 8192, XTAB_WORD0 = 4096;
__host__ __device__ constexpr int pc_word(int l, int k, int pm) { return PC_WORD0 + ((l * 3 + k) * 128 + pm) * 32; }
constexpr size_t WS_WA1 = 1 * MiB;
constexpr size_t WS_WA2 = 8 * MiB;
constexpr size_t WS_WPA = 13 * MiB;
constexpr size_t WS_WPH = 14 * MiB;
constexpr size_t WS_WOUT = 15 * MiB;
constexpr size_t WS_WC2 = 4 * MiB;
constexpr size_t WS_FT = 476 * MiB;
constexpr size_t WS_RS = 25 * MiB;
constexpr size_t WS_PART = 26 * MiB;
constexpr size_t WS_XB = 28 * MiB;
constexpr size_t WS_Q = 92 * MiB;
constexpr size_t WS_K = 124 * MiB;
constexpr size_t WS_ZA = 156 * MiB;
constexpr size_t WS_GA = 188 * MiB;
constexpr size_t WS_GH = 252 * MiB;
constexpr size_t WS_UT = 316 * MiB;
constexpr size_t WS_END = 508 * MiB;
#ifndef PROBE_DUP
#define PROBE_DUP 0
#endif
#ifndef PROBE_MODE
#define PROBE_MODE 0
#endif

constexpr int LDS_BYTES = 160 * 1024;
constexpr int MISC_OFF = LDS_BYTES - 256;

__device__ __forceinline__ unsigned cvt_pk_bf16(float lo, float hi) { unsigned r; asm volatile("v_cvt_pk_bf16_f32 %0, %1, %2" : "=v"(r) : "v"(lo), "v"(hi)); return r; }
__device__ __forceinline__ float bf_lo(unsigned w) { return __uint_as_float(w << 16); }
__device__ __forceinline__ float bf_hi(unsigned w) { return __uint_as_float(w & 0xffff0000u); }
__device__ __forceinline__ float bf2f(bf16_t h) { return __uint_as_float(((unsigned)h) << 16); }
__device__ __forceinline__ float shx(float v, int o, int lane) { return __uint_as_float((unsigned)__builtin_amdgcn_ds_bpermute((lane ^ o) << 2, (int)__float_as_uint(v))); }
__device__ __forceinline__ float sum_halves(float v) { const auto rr = __builtin_amdgcn_permlane32_swap(__float_as_uint(v), __float_as_uint(v), false, false); return __uint_as_float(rr[0]) + __uint_as_float(rr[1]); }
__device__ __forceinline__ float wave_sum(float v, int lane) {
#pragma unroll
    for (int o = 1; o < 32; o <<= 1) v += shx(v, o, lane);
    return sum_halves(v);
}
typedef __amdgpu_buffer_rsrc_t rsrc_t;
__device__ __forceinline__ rsrc_t wt_rsrc(const void* base, unsigned nbytes) { return __builtin_amdgcn_make_buffer_rsrc((void*)base, 0, (int)nbytes, 0x00020000); }
__device__ __forceinline__ void wt_store16(rsrc_t r, unsigned off, u32x4 v) { __builtin_amdgcn_raw_buffer_store_b128(v, r, (int)off, 0, 16); }
__device__ __forceinline__ void wt_store4(rsrc_t r, unsigned off, float v) { __builtin_amdgcn_raw_buffer_store_b32(__float_as_uint(v), r, (int)off, 0, 16); }
__device__ __forceinline__ void attn_glds(const void* gsrc, unsigned ldsdst) { unsigned keep_;
    asm volatile("s_mov_b32 %0, m0\n\ts_mov_b32 m0, %2\n\ts_nop 0\n\tglobal_load_lds_dwordx4 %1, off\n\ts_mov_b32 m0, %0" : "=&s"(keep_) : "v"(gsrc), "s"(ldsdst) : "memory"); }
__device__ __forceinline__ int rebuild_tid(int wave) { unsigned ones_ = ~0u; asm volatile("" : "+s"(ones_)); int t = wave * 64 + (int)__builtin_amdgcn_mbcnt_hi(ones_, __builtin_amdgcn_mbcnt_lo(ones_, 0u)); asm volatile("" : "+v"(t)); return t; }
__device__ __forceinline__ float fast_sigmoid(float g) { return __builtin_amdgcn_rcpf(1.0f + __builtin_amdgcn_exp2f(-g * LOG2E)); }

namespace pg8 {
constexpr int BM = 256, BK = 64, HALF = 128, HTB = HALF * BK * 2, STAGE_BYTES = 8 * HTB, NXCD = 8, WGM = 4;
__host__ __device__ __forceinline__ int lds_byte(int r, int c) { const int st = (r >> 4) * 2 + (c >> 5), rr = r & 15, cc = c & 31, ob = rr * 64 + cc * 2; return st * 1024 + (ob ^ (((ob >> 9) & 1) << 5)); }
__host__ __device__ __forceinline__ void stage_rc(int b, int& R, int& C) { const int st = b / 1024, sb = b % 1024, swz = sb ^ (((sb >> 9) & 1) << 5); R = (st >> 1) * 16 + swz / 64; C = (st & 1) * 32 + (swz % 64) / 2; }
__host__ __device__ __forceinline__ int perm32(int rho) { const int n = rho >> 4, i = rho & 15; return 8 * (i >> 2) + 4 * n + (i & 3); }
struct Unit { int pm, pn; };
struct Gemm { const bf16_t* A; const bf16_t* Bt; int M, N, K; };
struct StaticOrder {
    int nM, nN, nwg, G, c, reps;
    __host__ __device__ void init(int M, int N, int G_, int c_, int reps_ = 1) { nM = M / BM; nN = N / BM; nwg = nM * nN; G = G_; c = c_; reps = reps_; }
    __host__ __device__ bool next(int i, Unit& u) const {
        if (reps > 1) { const int rounds = (nwg + G - 1) / G; if (i >= reps * rounds) return false; i %= rounds; }
        const long L = (long)i * G + c; if (L >= nwg) return false;
        int wgid = (int)L; { const int q = nwg / NXCD, r = nwg % NXCD, xcd = wgid % NXCD, off = wgid / NXCD; wgid = (xcd < r ? xcd * (q + 1) : r * (q + 1) + (xcd - r) * q) + off; }
        const int nig = WGM * nN, gid = wgid / nig, fm = gid * WGM, gsz = (nM - fm) < WGM ? (nM - fm) : WGM;
        u.pm = fm + ((wgid % nig) % gsz); u.pn = (wgid % nig) / gsz; return true;
    }
    __device__ __forceinline__ void a_ready(const Unit&) const {}
    __device__ __forceinline__ void done(const Unit&) const {}
};
struct PairOrder {
    int pm, pn0;
    __device__ __forceinline__ bool next(int i, Unit& u) const { if (i >= 2) return false; u.pm = pm; u.pn = pn0 + i; return true; }
    __device__ __forceinline__ void a_ready(const Unit&) const {}
    __device__ __forceinline__ void done(const Unit&) const {}
};

__device__ __forceinline__ unsigned trimg_off(unsigned row, unsigned ch) { return 256u * row + 16u * (ch ^ (((row & 3u) << 2) | ((row >> 2) & 3u))); }
template <int OFF> __device__ __forceinline__ u32x2 tr_rd(unsigned addr) { u32x2 r; asm volatile("ds_read_b64_tr_b16 %0, %1 offset:%2" : "=&v"(r) : "v"(addr), "i"(OFF) : "memory"); return r; }
template <class Epi, class Sched, bool ALIGN_EPI = true, bool SP2 = true, bool ATR = false>
__device__ __forceinline__ void gemm_phase(LAS unsigned char* lds, const Gemm g, const Sched& S, const Epi& E, const int tid) {
    const int wid = __builtin_amdgcn_readfirstlane(tid >> 6), lane = tid & 63, wr = wid >> 2, wc = wid & 3, fr = lane & 15, fq = lane >> 4;
    const int K = g.K, nt = K / BK;
    unsigned voffA[2], voffB[2];
#pragma unroll
    for (int i = 0; i < 2; ++i) { int R, C; stage_rc(tid * 16 + i * 8192, R, C); const int Rb = Epi::PERM ? ((R & ~31) + perm32(R & 31)) : R;
        voffA[i] = (unsigned)(R * K + C) * 2u; voffB[i] = (unsigned)(Rb * K + C) * 2u;
        if constexpr (ATR) { const unsigned P = (unsigned)tid * 16u + (unsigned)i * 8192u, kr = P >> 8, cp = (P & 255u) >> 4, ch = cp ^ (((kr & 3u) << 2) | ((kr >> 2) & 3u));
            voffA[i] = kr * (unsigned)(MTOK * 2) + ch * 16u; } }
    const size_t kstep = (size_t)(BK * 2);
    const size_t hstep = (size_t)HALF * K * 2;
    const size_t tstep = 2 * hstep;
    const size_t kstepA = ATR ? (size_t)BK * MTOK * 2 : kstep, hstepA = ATR ? (size_t)HALF * 2 : hstep, tstepA = ATR ? (size_t)BM * 2 : tstep;
    unsigned tra[2][4];
    if constexpr (ATR) { const unsigned g_ = (unsigned)lane >> 4, q_ = ((unsigned)lane & 15u) >> 2, p_ = (unsigned)lane & 3u;
#pragma unroll
        for (int t_ = 0; t_ < 2; ++t_)
#pragma unroll
            for (int m_ = 0; m_ < 4; ++m_) tra[t_][m_] = (unsigned)(size_t)lds + trimg_off(8u * g_ + 4u * (unsigned)t_ + q_, 2u * (4u * (unsigned)wr + (unsigned)m_) + (p_ >> 1)) + 8u * (p_ & 1u); }
    u32x2 trv[4][2][2];
    const unsigned ldsw = (unsigned)wid * 1024u;
    const int aoff = lds_byte(wr * 64 + fr, fq * 8), boff = lds_byte(wc * 32 + fr, fq * 8);
#define PG8_SA(b, h) (((b) * 2 + (h)) * HTB)
#define PG8_SB(b, h) ((4 + (b) * 2 + (h)) * HTB)
#define PG8_STAGE(bufoff, gbase, voff) do { _Pragma("unroll") for (int _i = 0; _i < 2; ++_i) \
        __builtin_amdgcn_global_load_lds((const unsigned*)((const char*)(gbase) + (voff)[_i]), (LAS unsigned*)(lds + (bufoff) + ldsw + _i * 8192), 16, 0, 0); } while (0)
#define PG8_TR1(m, kk, b, h) do { trv[m][kk][0] = tr_rd<PG8_SA(b, h) + 8192 * (kk)>(tra[0][m]); trv[m][kk][1] = tr_rd<PG8_SA(b, h) + 8192 * (kk)>(tra[1][m]); } while (0)
#define PG8_LDA(dst, b, h) do { if constexpr (ATR) { PG8_TR1(0, 0, b, h); PG8_TR1(0, 1, b, h); PG8_TR1(1, 0, b, h); PG8_TR1(1, 1, b, h); PG8_TR1(2, 0, b, h); PG8_TR1(2, 1, b, h); PG8_TR1(3, 0, b, h); PG8_TR1(3, 1, b, h); } \
        else { _Pragma("unroll") for (int m = 0; m < 4; ++m) _Pragma("unroll") for (int k = 0; k < 2; ++k) dst[m][k] = *(const LAS bf16x8*)(lds + PG8_SA(b, h) + aoff + m * 2048 + k * 1024); } } while (0)
#define PG8_LDA_FIN(dst) do { if constexpr (ATR) { asm volatile("s_waitcnt lgkmcnt(0)" : "+v"(trv[0][0][0]), "+v"(trv[0][0][1]), "+v"(trv[0][1][0]), "+v"(trv[0][1][1]), "+v"(trv[1][0][0]), "+v"(trv[1][0][1]), "+v"(trv[1][1][0]), "+v"(trv[1][1][1]), \
            "+v"(trv[2][0][0]), "+v"(trv[2][0][1]), "+v"(trv[2][1][0]), "+v"(trv[2][1][1]), "+v"(trv[3][0][0]), "+v"(trv[3][0][1]), "+v"(trv[3][1][0]), "+v"(trv[3][1][1]) :: "memory"); \
        _Pragma("unroll") for (int m = 0; m < 4; ++m) _Pragma("unroll") for (int k = 0; k < 2; ++k) { const u32x4 w_ = {trv[m][k][0].x, trv[m][k][0].y, trv[m][k][1].x, trv[m][k][1].y}; dst[m][k] = __builtin_bit_cast(bf16x8, w_); } } } while (0)
#define PG8_LDB(dst, b, h) do { _Pragma("unroll") for (int n = 0; n < 2; ++n) _Pragma("unroll") for (int k = 0; k < 2; ++k) dst[n][k] = *(const LAS bf16x8*)(lds + PG8_SB(b, h) + boff + n * 2048 + k * 1024); } while (0)
#define PG8_MMA(ai, bj, At, Bt) do { __builtin_amdgcn_s_setprio(1); _Pragma("unroll") for (int m = 0; m < 4; ++m) _Pragma("unroll") for (int n = 0; n < 2; ++n) _Pragma("unroll") for (int k = 0; k < 2; ++k) \
        acc[ai][bj][m][n] = __builtin_amdgcn_mfma_f32_16x16x32_bf16(Bt[n][k], At[m][k], acc[ai][bj][m][n], 0, 0, 0); __builtin_amdgcn_s_setprio(0); } while (0)
#define PG8_WAIT_V(n) asm volatile("s_waitcnt vmcnt(" #n ")" ::: "memory")
#define PG8_WAIT_L(n) asm volatile("s_waitcnt lgkmcnt(" #n ")" ::: "memory")
#define PG8_BAR __builtin_amdgcn_s_barrier()
#define PG8_SCHED __builtin_amdgcn_sched_barrier(0)
    Unit cur, nxt; int ui = 0;
    if (!S.next(0, cur)) return;
    f32x4 acc[2][2][4][2];
#pragma unroll
    for (int a = 0; a < 2; ++a)
#pragma unroll
        for (int b = 0; b < 2; ++b)
#pragma unroll
            for (int m = 0; m < 4; ++m)
#pragma unroll
                for (int n = 0; n < 2; ++n) acc[a][b][m][n] = (f32x4){0.f, 0.f, 0.f, 0.f};
    bf16x8 At[4][2], B0[2][2], B1[2][2];
    const char* cA = (const char*)g.A + (size_t)cur.pm * tstepA; const char* cB = (const char*)g.Bt + (size_t)cur.pn * tstep;
    S.a_ready(cur);
    if constexpr (SP2) {
        PG8_STAGE(PG8_SB(0, 0), cB, voffB); PG8_STAGE(PG8_SB(0, 1), cB + hstep, voffB); PG8_STAGE(PG8_SA(0, 0), cA, voffA); PG8_STAGE(PG8_SA(0, 1), cA + hstepA, voffA);
        if (wr == 1) PG8_BAR;
        PG8_WAIT_V(2); PG8_BAR;
        PG8_STAGE(PG8_SB(1, 0), cB + kstep, voffB); PG8_STAGE(PG8_SA(1, 0), cA + kstepA, voffA); PG8_STAGE(PG8_SB(1, 1), cB + hstep + kstep, voffB);
        PG8_WAIT_V(6); PG8_BAR;
    } else {
        PG8_STAGE(PG8_SB(0, 0), cB, voffB); PG8_STAGE(PG8_SA(0, 0), cA, voffA); PG8_STAGE(PG8_SB(0, 1), cB + hstep, voffB); PG8_STAGE(PG8_SA(0, 1), cA + hstep, voffA);
        if (wr == 1) PG8_BAR;
        PG8_WAIT_V(4); PG8_BAR;
        PG8_STAGE(PG8_SB(1, 0), cB + kstep, voffB); PG8_STAGE(PG8_SA(1, 0), cA + kstep, voffA); PG8_STAGE(PG8_SB(1, 1), cB + hstep + kstep, voffB);
        PG8_WAIT_V(6); PG8_BAR;
    }
    for (;;) {
        const bool has_next = S.next(ui + 1, nxt);
        typename Epi::Pre pre; E.prefetch(pre, cur, wr, wc, fr, fq);
        const char* nA = has_next ? (const char*)g.A + (size_t)nxt.pm * tstepA : cA; const char* nB = has_next ? (const char*)g.Bt + (size_t)nxt.pn * tstep : cB;
        for (int t = 0; t < nt; t += 2) {
            const bool last = (t == nt - 2);
            const char* a1 = cA + (size_t)(t + 1) * kstepA;
            const char* a2 = last ? nA : cA + (size_t)(t + 2) * kstepA; const char* b2 = last ? nB : cB + (size_t)(t + 2) * kstep;
            const char* a3 = a2 + kstepA; const char* b3 = b2 + kstep;
            if (last && has_next) S.a_ready(nxt);
            if constexpr (SP2) {
            PG8_LDB(B0, 0, 0); PG8_LDB(B1, 0, 1); PG8_SCHED; PG8_LDA(At, 0, 0); PG8_STAGE(PG8_SA(1, 1), a1 + hstepA, voffA);
            PG8_WAIT_V(8); PG8_WAIT_L(0); PG8_LDA_FIN(At); PG8_BAR; PG8_MMA(0, 0, At, B0); PG8_MMA(0, 1, At, B1); PG8_BAR; PG8_SCHED;
            PG8_LDA(At, 0, 1); PG8_STAGE(PG8_SB(0, 0), b2, voffB); PG8_STAGE(PG8_SB(0, 1), b2 + hstep, voffB); PG8_STAGE(PG8_SA(0, 0), a2, voffA);
            PG8_WAIT_V(8); PG8_WAIT_L(0); PG8_LDA_FIN(At); PG8_BAR; PG8_MMA(1, 0, At, B0); PG8_MMA(1, 1, At, B1); PG8_BAR; PG8_SCHED;
            PG8_LDB(B0, 1, 0); PG8_LDB(B1, 1, 1); PG8_SCHED; PG8_LDA(At, 1, 0); PG8_STAGE(PG8_SA(0, 1), a2 + hstepA, voffA);
            PG8_WAIT_V(8); PG8_WAIT_L(0); PG8_LDA_FIN(At); PG8_BAR; PG8_MMA(0, 0, At, B0); PG8_MMA(0, 1, At, B1); PG8_BAR; PG8_SCHED;
            PG8_LDA(At, 1, 1); PG8_STAGE(PG8_SB(1, 0), b3, voffB); PG8_STAGE(PG8_SB(1, 1), b3 + hstep, voffB); PG8_STAGE(PG8_SA(1, 0), a3, voffA);
            PG8_WAIT_V(8); PG8_WAIT_L(0); PG8_LDA_FIN(At); PG8_BAR; PG8_MMA(1, 0, At, B0); PG8_MMA(1, 1, At, B1); PG8_BAR; PG8_SCHED;
            } else {
            PG8_LDB(B0, 0, 0); PG8_SCHED; PG8_LDA(At, 0, 0); PG8_STAGE(PG8_SA(1, 1), a1 + hstep, voffA);
            PG8_WAIT_L(8); PG8_BAR; PG8_WAIT_L(0); PG8_MMA(0, 0, At, B0); PG8_BAR; PG8_SCHED;
            PG8_LDB(B1, 0, 1); PG8_STAGE(PG8_SB(0, 0), b2, voffB);
            PG8_BAR; PG8_WAIT_L(0); PG8_MMA(0, 1, At, B1); PG8_BAR;
            PG8_LDA(At, 0, 1); PG8_STAGE(PG8_SA(0, 0), a2, voffA);
            PG8_BAR; PG8_WAIT_L(0); PG8_MMA(1, 0, At, B0); PG8_BAR; PG8_SCHED;
            PG8_STAGE(PG8_SB(0, 1), b2 + hstep, voffB);
            PG8_WAIT_V(6); PG8_BAR; PG8_MMA(1, 1, At, B1); PG8_BAR;
            PG8_LDB(B0, 1, 0); PG8_SCHED; PG8_LDA(At, 1, 0); PG8_STAGE(PG8_SA(0, 1), a2 + hstep, voffA);
            PG8_WAIT_L(8); PG8_BAR; PG8_WAIT_L(0); PG8_MMA(0, 0, At, B0); PG8_BAR; PG8_SCHED;
            PG8_LDB(B1, 1, 1); PG8_STAGE(PG8_SB(1, 0), b3, voffB);
            PG8_BAR; PG8_WAIT_L(0); PG8_MMA(0, 1, At, B1); PG8_BAR;
            PG8_LDA(At, 1, 1); PG8_STAGE(PG8_SA(1, 0), a3, voffA);
            PG8_BAR; PG8_WAIT_L(0); PG8_MMA(1, 0, At, B0); PG8_BAR; PG8_SCHED;
            PG8_STAGE(PG8_SB(1, 1), b3 + hstep, voffB);
            PG8_WAIT_V(6); PG8_BAR; PG8_MMA(1, 1, At, B1); PG8_BAR;
            }
        }
        if constexpr (ALIGN_EPI) { if (wr == 0) PG8_BAR; }
        E(acc, cur, wr, wc, fr, fq, pre); S.done(cur);
        if (!has_next) break;
#pragma unroll
        for (int a = 0; a < 2; ++a)
#pragma unroll
            for (int b = 0; b < 2; ++b)
#pragma unroll
                for (int m = 0; m < 4; ++m)
#pragma unroll
                    for (int n = 0; n < 2; ++n) acc[a][b][m][n] = (f32x4){0.f, 0.f, 0.f, 0.f};
        cur = nxt; cA = nA; cB = nB; ++ui;
        if constexpr (ALIGN_EPI) { if (wr == 1) PG8_BAR; }
    }
    PG8_WAIT_V(0);
    if constexpr (!ALIGN_EPI) { if (wr == 0) PG8_BAR; }
    PG8_BAR;
#undef PG8_SA
#undef PG8_SB
#undef PG8_STAGE
#undef PG8_LDA
#undef PG8_LDA_FIN
#undef PG8_TR1
#undef PG8_LDB
#undef PG8_MMA
#undef PG8_WAIT_V
#undef PG8_WAIT_L
#undef PG8_BAR
#undef PG8_SCHED
}

struct EpiA1 {
    static constexpr bool PERM = true;
    const float* rs; bf16_t *Q, *K, *ZA, *GA, *GH;
    struct Pre { float rsv[2][4]; };
    __device__ __forceinline__ void prefetch(Pre& p, const Unit& u, int wr, int wc, int fr, int fq) const {
        const int row0 = u.pm * BM + wr * 64 + fr;
#pragma unroll
        for (int ai = 0; ai < 2; ++ai)
#pragma unroll
            for (int m = 0; m < 4; ++m) p.rsv[ai][m] = rs[row0 + ai * HALF + m * 16];
    }
    __device__ __forceinline__ void operator()(const f32x4 (&acc)[2][2][4][2], const Unit& u, int wr, int wc, int fr, int fq, const Pre& p) const {
        bf16_t* base; int ld, colt; float sc = 1.f; const int pn = u.pn;
        if (pn < 2) { base = Q; ld = 512; colt = pn * 256; sc = QSCALE; }
        else if (pn < 4) { base = K; ld = 512; colt = (pn - 2) * 256; }
        else if (pn < 6) { base = ZA; ld = 512; colt = (pn - 4) * 256; }
        else if (pn < 10) { base = GA; ld = 1024; colt = (pn - 6) * 256; }
        else { base = GH; ld = 1024; colt = (pn - 10) * 256; }
        const int row0 = u.pm * BM + wr * 64 + fr, col0 = colt + wc * 32 + 8 * fq;
#pragma unroll
        for (int ai = 0; ai < 2; ++ai)
#pragma unroll
            for (int m = 0; m < 4; ++m) { const int row = row0 + ai * HALF + m * 16; const float s = p.rsv[ai][m] * sc; bf16_t* rowp = base + (size_t)row * ld + col0;
#pragma unroll
                for (int bj = 0; bj < 2; ++bj) { const f32x4 v0 = acc[ai][bj][m][0] * s, v1 = acc[ai][bj][m][1] * s;
                    u32x4 w; w.x = cvt_pk_bf16(v0[0], v0[1]); w.y = cvt_pk_bf16(v0[2], v0[3]); w.z = cvt_pk_bf16(v1[0], v1[1]); w.w = cvt_pk_bf16(v1[2], v1[3]);
                    *(u32x4*)(rowp + bj * HALF) = w; } }
    }
};
struct EpiA2 {
    static constexpr bool PERM = true;
    const float* rs; bf16_t* UT;
    struct Pre { f32x4 sv[2][2]; };
    __device__ __forceinline__ void prefetch(Pre& p, const Unit& u, int wr, int wc, int fr, int fq) const {
        const int col0 = u.pn * BM + wc * 32 + 8 * fq;
#pragma unroll
        for (int bj = 0; bj < 2; ++bj)
#pragma unroll
            for (int n = 0; n < 2; ++n) p.sv[bj][n] = *(const f32x4*)(rs + col0 + bj * HALF + 4 * n);
    }
    __device__ __forceinline__ void operator()(const f32x4 (&acc)[2][2][4][2], const Unit& u, int wr, int wc, int fr, int fq, const Pre& p) const {
        const int row0 = u.pm * BM + wr * 64 + fr, col0 = u.pn * BM + wc * 32 + 8 * fq;
#pragma unroll
        for (int ai = 0; ai < 2; ++ai)
#pragma unroll
            for (int m = 0; m < 4; ++m) { bf16_t* rowp = UT + (size_t)(row0 + ai * HALF + m * 16) * MTOK + col0;
#pragma unroll
                for (int bj = 0; bj < 2; ++bj) { const f32x4 v0 = acc[ai][bj][m][0] * p.sv[bj][0], v1 = acc[ai][bj][m][1] * p.sv[bj][1];
                    u32x4 w; w.x = cvt_pk_bf16(v0[0], v0[1]); w.y = cvt_pk_bf16(v0[2], v0[3]); w.z = cvt_pk_bf16(v1[0], v1[1]); w.w = cvt_pk_bf16(v1[2], v1[3]);
                    *(u32x4*)(rowp + bj * HALF) = w; } }
    }
};
struct EpiC1a {
    static constexpr bool PERM = true;
    bf16_t* GA; bf16_t* OUT;
    struct Pre { u32x4 g[4][2]; };
    __device__ __forceinline__ void loadh(u32x4 (&g)[4][2], int row0, int col0, int ai) const {
#pragma unroll
        for (int m = 0; m < 4; ++m)
#pragma unroll
            for (int bj = 0; bj < 2; ++bj) g[m][bj] = *(const u32x4*)(GA + (size_t)(row0 + ai * HALF + m * 16) * DM + col0 + bj * HALF);
    }
    __device__ __forceinline__ void prefetch(Pre& p, const Unit& u, int wr, int wc, int fr, int fq) const { loadh(p.g, u.pm * BM + wr * 64 + fr, u.pn * BM + wc * 32 + 8 * fq, 0); }
    __device__ __forceinline__ void half(const f32x4 (&acc)[2][2][4][2], const u32x4 (&gld)[4][2], int row0, int col0, int ai) const {
#pragma unroll
        for (int m = 0; m < 4; ++m) { bf16_t* rowp = GA + (size_t)(row0 + ai * HALF + m * 16) * DM + col0;
#pragma unroll
            for (int bj = 0; bj < 2; ++bj) { const u32x4 gv = gld[m][bj]; const f32x4 a0 = acc[ai][bj][m][0], a1 = acc[ai][bj][m][1];
                u32x4 w;
                w.x = cvt_pk_bf16(a0[0] * fast_sigmoid(bf_lo(gv.x)), a0[1] * fast_sigmoid(bf_hi(gv.x)));
                w.y = cvt_pk_bf16(a0[2] * fast_sigmoid(bf_lo(gv.y)), a0[3] * fast_sigmoid(bf_hi(gv.y)));
                w.z = cvt_pk_bf16(a1[0] * fast_sigmoid(bf_lo(gv.z)), a1[1] * fast_sigmoid(bf_hi(gv.z)));
                w.w = cvt_pk_bf16(a1[2] * fast_sigmoid(bf_lo(gv.w)), a1[3] * fast_sigmoid(bf_hi(gv.w)));
                *(u32x4*)(OUT + (rowp - GA) + bj * HALF) = w; } }
    }
    __device__ __forceinline__ void operator()(const f32x4 (&acc)[2][2][4][2], const Unit& u, int wr, int wc, int fr, int fq, const Pre& p) const {
        asm volatile("" : "+v"(fr), "+v"(fq));
        const int row0 = u.pm * BM + wr * 64 + fr, col0 = u.pn * BM + wc * 32 + 8 * fq;
        u32x4 g1[4][2]; loadh(g1, row0, col0, 1);
        half(acc, p.g, row0, col0, 0);
        half(acc, g1, row0, col0, 1);
    }
};
struct EpiC1b {
    static constexpr bool PERM = true;
    const bf16_t* GA; const bf16_t* GH; bf16_t* OUT;
    struct Pre { u32x4 gld[2][2]; };
    __device__ __forceinline__ void loadq(u32x4 (&pld)[2][2], u32x4 (&gld)[2][2], int row0, int col0, int q) const { const int ai = q >> 1, mh = q & 1;
#pragma unroll
        for (int mm = 0; mm < 2; ++mm)
#pragma unroll
            for (int bj = 0; bj < 2; ++bj) { const size_t off = (size_t)(row0 + ai * HALF + (2 * mh + mm) * 16) * DM + col0 + bj * HALF; pld[mm][bj] = *(const u32x4*)(GA + off); gld[mm][bj] = *(const u32x4*)(GH + off); }
    }
    __device__ __forceinline__ void prefetch(Pre& p, const Unit& u, int wr, int wc, int fr, int fq) const { const int row0 = u.pm * BM + wr * 64 + fr, col0 = u.pn * BM + wc * 32 + 8 * fq;
#pragma unroll
        for (int mm = 0; mm < 2; ++mm)
#pragma unroll
            for (int bj = 0; bj < 2; ++bj) p.gld[mm][bj] = *(const u32x4*)(GH + (size_t)(row0 + mm * 16) * DM + col0 + bj * HALF); }
    __device__ __forceinline__ void quarter(const f32x4 (&acc)[2][2][4][2], const u32x4 (&pld)[2][2], const u32x4 (&gld)[2][2], int row0, int col0, int q) const { const int ai = q >> 1, mh = q & 1;
#pragma unroll
        for (int mm = 0; mm < 2; ++mm) { const int m = 2 * mh + mm; const size_t off = (size_t)(row0 + ai * HALF + m * 16) * DM + col0;
#pragma unroll
            for (int bj = 0; bj < 2; ++bj) { const u32x4 pv = pld[mm][bj]; const u32x4 gv = gld[mm][bj];
                const f32x4 a0 = acc[ai][bj][m][0], a1 = acc[ai][bj][m][1];
                u32x4 w;
                w.x = cvt_pk_bf16(bf_lo(pv.x) + a0[0] * fast_sigmoid(bf_lo(gv.x)), bf_hi(pv.x) + a0[1] * fast_sigmoid(bf_hi(gv.x)));
                w.y = cvt_pk_bf16(bf_lo(pv.y) + a0[2] * fast_sigmoid(bf_lo(gv.y)), bf_hi(pv.y) + a0[3] * fast_sigmoid(bf_hi(gv.y)));
                w.z = cvt_pk_bf16(bf_lo(pv.z) + a1[0] * fast_sigmoid(bf_lo(gv.z)), bf_hi(pv.z) + a1[1] * fast_sigmoid(bf_hi(gv.z)));
                w.w = cvt_pk_bf16(bf_lo(pv.w) + a1[2] * fast_sigmoid(bf_lo(gv.w)), bf_hi(pv.w) + a1[3] * fast_sigmoid(bf_hi(gv.w)));
                *(u32x4*)(OUT + off + bj * HALF) = w; } }
    }
    __device__ __forceinline__ void operator()(const f32x4 (&acc)[2][2][4][2], const Unit& u, int wr, int wc, int fr, int fq, const Pre& p) const {
        asm volatile("" : "+v"(fr), "+v"(fq));
        const int row0 = u.pm * BM + wr * 64 + fr, col0 = u.pn * BM + wc * 32 + 8 * fq;
        u32x4 pa[2][2], ga[2][2], pb[2][2], gb[2][2], p0[2][2];
#pragma unroll
        for (int mm = 0; mm < 2; ++mm)
#pragma unroll
            for (int bj = 0; bj < 2; ++bj) p0[mm][bj] = *(const u32x4*)(GA + (size_t)(row0 + mm * 16) * DM + col0 + bj * HALF);
        loadq(pa, ga, row0, col0, 1); quarter(acc, p0, p.gld, row0, col0, 0);
        loadq(pb, gb, row0, col0, 2); quarter(acc, pa, ga, row0, col0, 1);
        loadq(pa, ga, row0, col0, 3); quarter(acc, pb, gb, row0, col0, 2);
        quarter(acc, pa, ga, row0, col0, 3);
    }
};
struct EpiC2 {
    static constexpr bool PERM = true;
    bf16_t* O; float* PART;
    struct Pre {};
    __device__ __forceinline__ void prefetch(Pre&, const Unit&, int, int, int, int) const {}
    __device__ __forceinline__ void operator()(const f32x4 (&acc)[2][2][4][2], const Unit& u, int wr, int wc, int fr, int fq, const Pre&) const {
        const int row0 = u.pm * BM + wr * 64 + fr, col0 = u.pn * BM + wc * 32 + 8 * fq;
#pragma unroll
        for (int ai = 0; ai < 2; ++ai)
#pragma unroll
            for (int m = 0; m < 4; ++m) { const int row = row0 + ai * HALF + m * 16; bf16_t* rowp = O + (size_t)row * DM + col0; float ss = 0.f;
#pragma unroll
                for (int bj = 0; bj < 2; ++bj) { const f32x4 v0 = acc[ai][bj][m][0], v1 = acc[ai][bj][m][1];
                    ss += (v0[0] * v0[0] + v0[1] * v0[1]) + (v0[2] * v0[2] + v0[3] * v0[3]) + (v1[0] * v1[0] + v1[1] * v1[1]) + (v1[2] * v1[2] + v1[3] * v1[3]);
                    u32x4 w; w.x = cvt_pk_bf16(v0[0], v0[1]); w.y = cvt_pk_bf16(v0[2], v0[3]); w.z = cvt_pk_bf16(v1[0], v1[1]); w.w = cvt_pk_bf16(v1[2], v1[3]);
                    *(u32x4*)(rowp + bj * HALF) = w; }
                ss += shx(ss, 16, fq * 16 + fr); ss = sum_halves(ss);
                if (fq == 0) PART[((size_t)u.pn * MTOK + row) * 4 + wc] = ss; }
    }
};
}

#define XB_TMO      128
#define XB_XCNT(j)  (256  + 64 * (j))
#define XB_XSUB(j)  (1280 + 64 * (j))
#define XB_XGEN(j)  (2304 + 64 * (j))
#define XB_TOP      3328
#define XB_TOPGEN   3392
#define XCD_BAR_WORDS 3456
#define XB_SPIN_CAP (1u << 18)
__device__ __forceinline__ unsigned xb_ld(unsigned* p)              { return __hip_atomic_load(p, __ATOMIC_RELAXED, __HIP_MEMORY_SCOPE_AGENT); }
__device__ __forceinline__ unsigned xb_add(unsigned* p, unsigned v) { return __hip_atomic_fetch_add(p, v, __ATOMIC_RELAXED, __HIP_MEMORY_SCOPE_AGENT); }
__device__ __forceinline__ unsigned xb_xcc_id() { return (unsigned)__builtin_amdgcn_s_getreg((3 << 11) | 20) & 0xFu; }
#define XB_SPIN(cond, bar) do { unsigned _sp = 0; while (cond) { __builtin_amdgcn_s_sleep(1); \
    if ((++_sp & 255u) == 0u) { if (xb_ld(&(bar)[XB_TMO])) break; if (_sp > XB_SPIN_CAP) { atomicAdd(&(bar)[XB_TMO], 1u); break; } } } } while (0)
struct XcdBarrier { unsigned* bar; unsigned x; volatile LAS unsigned* st; };
__device__ __forceinline__ XcdBarrier xcd_barrier_post(unsigned* bar, volatile LAS unsigned* st) {
    XcdBarrier b; b.bar = bar; b.x = xb_xcc_id(); b.st = st;
    if (threadIdx.x == 0) (void)xb_add(&bar[XB_XCNT(b.x)], 1u);
    return b;
}
__device__ __forceinline__ void xcd_barrier_complete(unsigned* bar, unsigned x, unsigned& nloc, unsigned& nx) {
    const unsigned G = gridDim.x * gridDim.y * gridDim.z;
    unsigned sum, cnt, mine, sp = 0u;
    for (;;) {
        sum = 0u; cnt = 0u; mine = 0u;
#pragma unroll
        for (unsigned j = 0; j < 16; ++j) { const unsigned c = xb_ld(&bar[XB_XCNT(j)]); sum += c; cnt += (c > 0u) ? 1u : 0u; mine = (j == x) ? c : mine; }
        if (sum == G) break;
        __builtin_amdgcn_s_sleep(1);
        if ((++sp & 255u) == 0u) { if (xb_ld(&bar[XB_TMO])) break; if (sp > XB_SPIN_CAP) { atomicAdd(&bar[XB_TMO], 1u); break; } }
    }
    nloc = mine > 0u ? mine : 1u; nx = cnt > 0u ? cnt : 1u;
}
__device__ __forceinline__ void xcd_barrier(const XcdBarrier& b) {
    asm volatile("s_waitcnt vmcnt(0)" ::: "memory");
    __syncthreads();
    if (threadIdx.x == 0) {
        unsigned* bar = b.bar;
        __builtin_amdgcn_s_waitcnt(0);
        unsigned nloc = b.st[0], nx = b.st[1];
        if (nloc == 0u) { xcd_barrier_complete(bar, b.x, nloc, nx); b.st[0] = nloc; b.st[1] = nx; }
        const unsigned old = xb_add(&bar[XB_XSUB(b.x)], 1u);
        const unsigned gen = old / nloc;
        if (old + 1u == (gen + 1u) * nloc) {
            __builtin_amdgcn_fence(__ATOMIC_RELEASE, "agent");
            asm volatile("s_waitcnt vmcnt(0)" ::: "memory");
            const unsigned og = xb_add(&bar[XB_TOP], 1u);
            const unsigned tg = og / nx;
            __builtin_amdgcn_fence(__ATOMIC_ACQUIRE, "agent");
            if (og + 1u == (tg + 1u) * nx) xb_add(&bar[XB_TOPGEN], 1u);
            else XB_SPIN(xb_ld(&bar[XB_TOPGEN]) == tg, bar);
            xb_add(&bar[XB_XGEN(b.x)], 1u);
            asm volatile("s_waitcnt vmcnt(0)" ::: "memory");
        } else {
            __builtin_amdgcn_fence(__ATOMIC_ACQUIRE, "agent");
            XB_SPIN(xb_ld(&bar[XB_XGEN(b.x)]) == gen, bar);
            asm volatile("s_waitcnt vmcnt(0)" ::: "memory");
        }
    }
    __syncthreads();
}

__device__ __forceinline__ void pair_post(unsigned* cnt, bool samex, int tid) {
    asm volatile("s_waitcnt vmcnt(0)" ::: "memory");
    __syncthreads();
    if (tid < 64) {
        if (!samex) { __builtin_amdgcn_fence(__ATOMIC_RELEASE, "agent"); asm volatile("s_waitcnt vmcnt(0)" ::: "memory"); }
        if (tid == 0) (void)xb_add(cnt, 1u);
    }
}
__device__ __forceinline__ void pair_wait(unsigned* ctl, unsigned* cnt, unsigned need, int tid) {
    if (tid < 64) {
        unsigned sp = 0;
        __builtin_amdgcn_fence(__ATOMIC_ACQUIRE, "agent");
        while ((unsigned)__builtin_amdgcn_readfirstlane(xb_ld(cnt)) < need) { __builtin_amdgcn_s_sleep(1);
            if ((++sp & 255u) == 0u) { if (__builtin_amdgcn_readfirstlane(xb_ld(&ctl[XB_TMO]))) break; if (sp > XB_SPIN_CAP) { if (tid == 0) atomicAdd(&ctl[XB_TMO], 1u); break; } } }
        asm volatile("s_waitcnt vmcnt(0)" ::: "memory");
    }
    __syncthreads();
}

enum { I_X = 0, I_RELB, I_PRE, I_POST, I_WIN, I_LQ1, I_LK1, I_LQ2, I_LK2, I_SUBLN, I_CW, I_CB, I_FW1, I_FB1, I_FW2, I_FB2, I_FW3, I_FB3, I_FFREQ, I_FWOUT, I_FDELTA, I_FBIAS, I_WPA, I_WPH, I_WOUT, N_IN };
struct Args { const float* in[N_IN]; float* out; unsigned char* ws; int ph_lo, ph_hi; };

typedef const __attribute__((address_space(4))) unsigned char* kargp_t;
__device__ __forceinline__ kargp_t kargs_base() { kargp_t p = (kargp_t)__builtin_amdgcn_kernarg_segment_ptr(); asm volatile("" : "+s"(p)); return p; }
__device__ __forceinline__ const float* kin(int i) { return *(const float* const __attribute__((address_space(4)))*)(kargs_base() + 8 * i); }
__device__ __forceinline__ float* kout() { return *(float* const __attribute__((address_space(4)))*)(kargs_base() + 8 * N_IN); }
__device__ __forceinline__ unsigned char* kws() { return *(unsigned char* const __attribute__((address_space(4)))*)(kargs_base() + 8 * N_IN + 8); }


__device__ __forceinline__ void norm_rows(const Args& a, int lnext, int rbeg, int rend, int rstep, int lane, const bool dummy = false) {
    unsigned char* ws = kws();
    const float* xin = kin(I_X); float* out = kout();
    const bf16_t* O = (const bf16_t*)(ws + WS_GH); const float* PART = (const float*)(ws + WS_PART);
    const bf16_t* XB = (const bf16_t*)(ws + WS_XB); bf16_t* XBo = dummy ? (bf16_t*)out : (bf16_t*)(ws + WS_XB); float* RS = dummy ? out + (size_t)16 * MiB : (float*)(ws + WS_RS);
    f32x4 gpost[4];
    if (lnext > 0) {
#pragma unroll
        for (int j = 0; j < 4; ++j) gpost[j] = *(const f32x4*)(kin(I_POST) + (size_t)(lnext - 1) * DM + 4 * lane + 256 * j);
    }
    constexpr int NB = 8;
    for (int row0 = rbeg; row0 < rend; row0 += NB * rstep) {
        f32x4 xf[NB][4]; u32x2 xw[NB][4], ow[NB][4]; float pp[NB];
#pragma unroll
        for (int i = 0; i < NB; ++i) { const int row = (row0 + i * rstep < rend) ? row0 + i * rstep : row0;
            if (lnext == 0) {
#pragma unroll
                for (int j = 0; j < 4; ++j) xf[i][j] = *(const f32x4*)(xin + (size_t)row * DM + 4 * lane + 256 * j);
            } else {
#pragma unroll
                for (int j = 0; j < 4; ++j) { xw[i][j] = *(const u32x2*)(XB + (size_t)row * DM + 4 * lane + 256 * j); ow[i][j] = *(const u32x2*)(O + (size_t)row * DM + 4 * lane + 256 * j); }
                pp[i] = PART[((size_t)((lane & 15) >> 2) * MTOK + row) * 4 + (lane & 3)]; } }
#pragma unroll
        for (int i = 0; i < NB; ++i) { const int row = row0 + i * rstep; if (row >= rend) break;
            f32x4 v[4];
            if (lnext == 0) {
#pragma unroll
                for (int j = 0; j < 4; ++j) v[j] = xf[i][j];
            } else {
                const float rso = __builtin_amdgcn_rsqf(wave_sum(lane < 16 ? pp[i] : 0.f, lane) * (1.0f / DM) + 1e-6f);
#pragma unroll
                for (int j = 0; j < 4; ++j) {
                    v[j][0] = bf_lo(xw[i][j].x) + bf_lo(ow[i][j].x) * rso * gpost[j][0]; v[j][1] = bf_hi(xw[i][j].x) + bf_hi(ow[i][j].x) * rso * gpost[j][1];
                    v[j][2] = bf_lo(xw[i][j].y) + bf_lo(ow[i][j].y) * rso * gpost[j][2]; v[j][3] = bf_hi(xw[i][j].y) + bf_hi(ow[i][j].y) * rso * gpost[j][3]; }
            }
            if (lnext < DEPTH) {
                float sq = 0.f;
#pragma unroll
                for (int j = 0; j < 4; ++j) sq += (v[j][0] * v[j][0] + v[j][1] * v[j][1]) + (v[j][2] * v[j][2] + v[j][3] * v[j][3]);
                sq = wave_sum(sq, lane);
                if (lane == 0) RS[row] = __builtin_amdgcn_rsqf(sq * (1.0f / DM) + 1e-6f);
#pragma unroll
                for (int j = 0; j < 4; ++j) { u32x2 w; w.x = cvt_pk_bf16(v[j][0], v[j][1]); w.y = cvt_pk_bf16(v[j][2], v[j][3]); *(u32x2*)(XBo + (size_t)row * DM + 4 * lane + 256 * j) = w; }
            } else {
#pragma unroll
                for (int j = 0; j < 4; ++j) *(f32x4*)(out + (size_t)row * DM + 4 * lane + 256 * j) = v[j];
            }
        }
    }
}
__device__ __forceinline__ void transpose_item(const float* W, int ldw, int k0, int nsrc0, const float* gain, bf16_t* WT, int ldt, int ndst0, LAS float* scr, int lane) {
#pragma unroll 1
    for (int kb = 0; kb < 64; kb += 32) { float v[32], gv[32];
#pragma unroll
        for (int i = 0; i < 32; ++i) v[i] = W[(size_t)(k0 + kb + i) * ldw + nsrc0 + lane];
        if (gain) {
#pragma unroll
            for (int i = 0; i < 32; ++i) gv[i] = gain[k0 + kb + i];
#pragma unroll
            for (int i = 0; i < 32; ++i) v[i] *= gv[i]; }
#pragma unroll
        for (int i = 0; i < 32; ++i) scr[(kb + i) * 65 + lane] = v[i]; }
    asm volatile("s_waitcnt lgkmcnt(0)" ::: "memory");
#pragma unroll
    for (int it = 0; it < 8; ++it) { const int q = it * 64 + lane, n = q >> 3, kc = q & 7; const LAS float* s = scr + (8 * kc) * 65 + n;
        u32x4 o; o.x = cvt_pk_bf16(s[0 * 65], s[1 * 65]); o.y = cvt_pk_bf16(s[2 * 65], s[3 * 65]); o.z = cvt_pk_bf16(s[4 * 65], s[5 * 65]); o.w = cvt_pk_bf16(s[6 * 65], s[7 * 65]);
        *(u32x4*)(WT + (size_t)(ndst0 + n) * ldt + k0 + 8 * kc) = o; }
    asm volatile("s_waitcnt lgkmcnt(0)" ::: "memory");
}
__device__ __forceinline__ void convert_weights(const Args& a, int l, LAS unsigned char* lds, int gw, int NGW, int wave, int lane) {
    unsigned char* ws = kws();
    LAS float* scr = (LAS float*)(lds + wave * 16640);
    const float* win = kin(I_WIN) + (size_t)l * DM * WIN; const float* gain = kin(I_PRE) + (size_t)l * DM;
    const float* wpa = kin(I_WPA) + (size_t)l * 512 * DM; const float* wph = kin(I_WPH) + (size_t)l * 512 * DM; const float* wout = kin(I_WOUT) + (size_t)l * DM * DM;
    bf16_t* WA1 = (bf16_t*)(ws + WS_WA1); bf16_t* WA2 = (bf16_t*)(ws + WS_WA2); const size_t cset = (size_t)(l & 1) * WS_WC2; bf16_t* WPA = (bf16_t*)(ws + WS_WPA + cset); bf16_t* WPH = (bf16_t*)(ws + WS_WPH + cset); bf16_t* WOUT = (bf16_t*)(ws + WS_WOUT + cset);
    constexpr int I_IN = 16 * 96, I_PA = 8 * 16, I_PH = 8 * 16, I_OUT = 16 * 16, NITEMS = I_IN + I_PA + I_PH + I_OUT;
    for (int it = gw; it < NITEMS; it += NGW) {
        int r = it;
        if (r < I_IN) { const int kb = r / 96, nb = r % 96; const int d0 = nb * 64;
            int src; bf16_t* dst; int drow;
            if (d0 < NA1) { dst = WA1; drow = d0; src = d0 < 1024 ? d0 : (d0 < 1536 ? 1536 + (d0 - 1024) : 4096 + (d0 - 1536)); }
            else { const int e = d0 - NA1; dst = WA2; drow = e; src = e < 512 ? 1024 + e : 2048 + (e - 512); }
            transpose_item(win, WIN, kb * 64, src, gain, dst, DM, drow, scr, lane); continue; }
        r -= I_IN;
        if (r < I_PA) { transpose_item(wpa, DM, (r / 16) * 64, (r % 16) * 64, nullptr, WPA, 512, (r % 16) * 64, scr, lane); continue; }
        r -= I_PA;
        if (r < I_PH) { transpose_item(wph, DM, (r / 16) * 64, (r % 16) * 64, nullptr, WPH, 512, (r % 16) * 64, scr, lane); continue; }
        r -= I_PH;
        transpose_item(wout, DM, (r / 16) * 64, (r % 16) * 64, nullptr, WOUT, DM, (r % 16) * 64, scr, lane);
    }
}
template <int K, int PITCH>
__device__ __forceinline__ void filt_layer(const LAS float* in, const float* W, const float* Bv, const float* fq, LAS float* out, int tid) {
    const int j = tid & 63, pg = tid >> 6;
    const float b0 = Bv[j]; float s0 = b0, s1 = b0, s2 = b0, s3 = b0, s4 = b0;
    const LAS float* r0 = in + pg * PITCH; const LAS float* r4 = in + 32 * PITCH;
    float wk[K];
#pragma unroll
    for (int k = 0; k < K; ++k) wk[k] = W[k * 64 + j];
#pragma unroll
    for (int k = 0; k < K; ++k) { const float w = wk[k];
        s0 += r0[k] * w; s1 += r0[8 * PITCH + k] * w; s2 += r0[16 * PITCH + k] * w; s3 += r0[24 * PITCH + k] * w; s4 += r4[k] * w; }
    const float f = fq[j];
    out[pg * 64 + j] = __builtin_amdgcn_sinf(f * s0 * 0.15915494309189535f); out[(pg + 8) * 64 + j] = __builtin_amdgcn_sinf(f * s1 * 0.15915494309189535f);
    out[(pg + 16) * 64 + j] = __builtin_amdgcn_sinf(f * s2 * 0.15915494309189535f); out[(pg + 24) * 64 + j] = __builtin_amdgcn_sinf(f * s3 * 0.15915494309189535f);
    if (pg == 0) out[32 * 64 + j] = __builtin_amdgcn_sinf(f * s4 * 0.15915494309189535f);
}
__device__ __forceinline__ void split_bf16x8(const float (&x)[8], bf16x8& hi, bf16x8& lo) {
    u32x4 h, l;
#pragma unroll
    for (int e = 0; e < 4; ++e) { const unsigned hw = cvt_pk_bf16(x[2 * e], x[2 * e + 1]); const unsigned lw = cvt_pk_bf16(x[2 * e] - bf_lo(hw), x[2 * e + 1] - bf_hi(hw)); h[e] = hw; l[e] = lw; }
    hi = __builtin_bit_cast(bf16x8, h); lo = __builtin_bit_cast(bf16x8, l);
}
__device__ __forceinline__ void make_filters(const Args& a, int l, LAS unsigned char* lds, int pb, int tid) {
    constexpr int NP = 33;
    LAS float* zs = (LAS float*)lds;
    LAS float* a1 = zs + NP * 36;
    LAS float* a2 = a1 + NP * 64;
    const float* w1 = kin(I_FW1) + (size_t)l * 33 * 64; const float* b1 = kin(I_FB1) + l * 64;
    const float* w2 = kin(I_FW2) + (size_t)l * 64 * 64; const float* b2 = kin(I_FB2) + l * 64;
    const float* w3 = kin(I_FW3) + (size_t)l * 64 * 64; const float* b3 = kin(I_FB3) + l * 64;
    const float* fq = kin(I_FFREQ) + l * 64; const float* wo = kin(I_FWOUT) + (size_t)l * 64 * 2048;
    const float* dl = kin(I_FDELTA) + l * 2048; const float* fb = kin(I_FBIAS) + l * 1024;
    bf16_t* FT = (bf16_t*)(kws() + WS_FT) + (size_t)l * (2 * 512 * 4096);
    const int i0 = pb * 32;
    __syncthreads();
    for (int idx = tid; idx < NP * 33; idx += NTHR) { const int p = idx / 33, k = idx % 33; const int i = i0 + p; float z;
        if (k == 0) z = (float)i * (1.0f / 2047.0f);
        else { const int j = (k - 1) & 15; const float f = 1e-4f + (float)j * ((15.0f - 1e-4f) / 15.0f); float ang = 6.283185307179586f * (float)i; ang = ang * f; ang = ang / 2048.0f;
            const float rev = ang * 0.15915494309189535f;
            z = (k <= 16) ? __builtin_amdgcn_cosf(rev) : -__builtin_amdgcn_sinf(rev); }
        zs[p * 36 + k] = z; }
    __syncthreads();
    filt_layer<33, 36>(zs, w1, b1, fq, a1, tid);
    __syncthreads();
    filt_layer<64, 64>(a1, w2, b2, fq, a2, tid);
    __syncthreads();
    filt_layer<64, 64>(a2, w3, b3, fq, a1, tid);
    __syncthreads();
    const int wave = tid >> 6, lane = tid & 63, li = lane & 15, lg = lane >> 4, dir = wave >> 2;
    bf16x8 Ah[2][2], Al[2][2];
#pragma unroll
    for (int mt = 0; mt < 2; ++mt)
#pragma unroll
        for (int ks = 0; ks < 2; ++ks) { const LAS float* src = a1 + (dir + 16 * mt + li) * 64 + 32 * ks + 8 * lg;
            const f32x4 x0 = *(const LAS f32x4*)src, x1 = *(const LAS f32x4*)(src + 4); const float x[8] = {x0[0], x0[1], x0[2], x0[3], x1[0], x1[1], x1[2], x1[3]};
            split_bf16x8(x, Ah[mt][ks], Al[mt][ks]); }
    float wn[2][8];
#pragma unroll
    for (int ks = 0; ks < 2; ++ks)
#pragma unroll
        for (int e = 0; e < 8; ++e) wn[ks][e] = wo[(size_t)(32 * ks + 8 * lg + e) * 2048 + 256 * wave + li];
#pragma unroll 2
    for (int nt = 0; nt < 16; ++nt) {
        const int fc = 256 * wave + 16 * nt + li;
        bf16x8 Bh[2], Bl[2];
#pragma unroll
        for (int ks = 0; ks < 2; ++ks) split_bf16x8(wn[ks], Bh[ks], Bl[ks]);
        { const int fn = 256 * wave + 16 * (nt < 15 ? nt + 1 : 15) + li;
#pragma unroll
          for (int ks = 0; ks < 2; ++ks)
#pragma unroll
              for (int e = 0; e < 8; ++e) wn[ks][e] = wo[(size_t)(32 * ks + 8 * lg + e) * 2048 + fn]; }
        f32x4 acc[2];
#pragma unroll
        for (int mt = 0; mt < 2; ++mt) { acc[mt] = (f32x4){0.f, 0.f, 0.f, 0.f};
#pragma unroll
            for (int ks = 0; ks < 2; ++ks) {
                acc[mt] = __builtin_amdgcn_mfma_f32_16x16x32_bf16(Al[mt][ks], Bh[ks], acc[mt], 0, 0, 0);
                acc[mt] = __builtin_amdgcn_mfma_f32_16x16x32_bf16(Ah[mt][ks], Bl[ks], acc[mt], 0, 0, 0);
                acc[mt] = __builtin_amdgcn_mfma_f32_16x16x32_bf16(Ah[mt][ks], Bh[ks], acc[mt], 0, 0, 0); } }
        const int o = (fc >> 9) & 1, c = fc & 511;
        const float dlt = fabsf(dl[fc]) * LOG2E, bvv = fb[o * 512 + c];
        bf16_t* row = FT + (size_t)(o * 512 + c) * 4096;
#pragma unroll
        for (int mt = 0; mt < 2; ++mt) { float v[4];
#pragma unroll
            for (int jj = 0; jj < 4; ++jj) { const int i = i0 + dir + 16 * mt + 4 * lg + jj; const float t = (float)i * (1.0f / 2047.0f);
                float x = acc[mt][jj] * __builtin_amdgcn_exp2f(-t * dlt); if (dir == 0 && i == 0) x += bvv; if (i > 2047) x = 0.f; v[jj] = x; }
            u32x2 w;
            if (dir == 0) { w.x = cvt_pk_bf16(v[0], v[1]); w.y = cvt_pk_bf16(v[2], v[3]); *(u32x2*)(row + 2048 + i0 + 16 * mt + 4 * lg) = w; }
            else { w.x = cvt_pk_bf16(v[3], v[2]); w.y = cvt_pk_bf16(v[1], v[0]); *(u32x2*)(row + 2044 - i0 - 16 * mt - 4 * lg) = w; } }
    }
}

constexpr int AT_KS = 0;
constexpr int AT_VS = 2 * 8192;
constexpr int AT_BT = AT_VS + 2 * 16384;
constexpr int AT_SL = AT_BT + 2048;
constexpr int AT_ST = AT_SL + 512;
constexpr int AT_QS = AT_ST + 8 * 2048 * 4;
static_assert(AT_QS + 8 * 4096 <= MISC_OFF, "attention LDS");
__device__ __forceinline__ int t5_bucket(int rel) {
    const int n = rel < 0 ? -rel : rel; const int base = rel > 0 ? 16 : 0; int v;
    if (n < 8) v = n; else if (n < 12) v = 8; else if (n < 16) v = 9; else if (n < 23) v = 10; else if (n < 32) v = 11; else if (n < 46) v = 12; else if (n < 64) v = 13; else if (n < 91) v = 14; else v = 15;
    return base + v;
}
__device__ __forceinline__ int swap23(int i) { return (i & ~12) | ((i & 4) << 1) | ((i & 8) >> 1); }

struct APre { u32x4 q[4]; };
__device__ __forceinline__ void attn_prefetch(APre& p, LAS unsigned char* lds, const bf16_t* Qb, const bf16_t* Kb, int b, int h, int c, int qb, int wave, int tid) {
    int tl = tid; asm volatile("" : "+v"(tl)); const int ln = tl & 63, ql = ln & 31, hi = ln >> 5;
    const int sR = 8 * wave + (ln >> 3), scl = (ln & 7) ^ ((sR >> 1) & 7);
    const bf16_t* kg = Kb + (size_t)(b * SEQ + ((sR & 32) | swap23(sR & 31))) * 512 + h * 128 + c * 64 + 8 * scl;
    const unsigned kd = (unsigned)(size_t)lds + AT_KS + 1024 * wave; unsigned keep_;
    asm volatile("s_mov_b32 %0, m0\n\ts_mov_b32 m0, %2\n\ts_nop 0\n\tglobal_load_lds_dwordx4 %1, off\n\ts_mov_b32 m0, %0" : "=&s"(keep_) : "v"(kg), "s"(kd) : "memory");
    asm volatile("s_mov_b32 %0, m0\n\ts_mov_b32 m0, %2\n\ts_nop 0\n\tglobal_load_lds_dwordx4 %1, off\n\ts_mov_b32 m0, %0" : "=&s"(keep_) : "v"(kg + (size_t)64 * 512), "s"(kd + 8192u) : "memory");
    const bf16_t* qp = Qb + (size_t)(b * SEQ + qb * 256 + wave * 32 + ql) * 512 + h * 128 + c * 64 + 8 * hi;
#pragma unroll
    for (int ks = 0; ks < 4; ++ks) attn_glds(qp + 16 * ks, (unsigned)(size_t)lds + AT_QS + wave * 4096 + ks * 1024);
    (void)p;
}
template <class PreTail>
__device__ __forceinline__ void attn_pass(LAS unsigned char* lds, const bf16_t* Qb, const bf16_t* Kb, const bf16_t* VT, int b, int h, int c, int qb, int wave, int lane, int tid, f32x16 (&O)[4], const int pmode, const APre& pin, const bool use_pin, PreTail&& pretail) {
    const int tmul = (pmode & 1) ? 0 : 1;
    { int tl = tid; asm volatile("" : "+v"(tl)); tid = tl; lane = tl & 63; }
    const int ql = lane & 31, hi = lane >> 5;
    const int qpos = qb * 256 + wave * 32 + ql;
    LAS unsigned char* qslot = lds + AT_QS + wave * 4096 + lane * 16;
#define AT_DMA_K(tile, bufi) __builtin_amdgcn_global_load_lds((const unsigned*)(kg + (size_t)(tile) * 64 * 512), (LAS unsigned*)(kdst + (bufi) * 8192), 16, 0, 0)
#define AT_DMA_V(tile, bufi) do { __builtin_amdgcn_global_load_lds((const unsigned*)(vg0 + (tile) * 64), (LAS unsigned*)(vdst + (bufi) * 16384), 16, 0, 0); \
                                  __builtin_amdgcn_global_load_lds((const unsigned*)(vg1 + (tile) * 64), (LAS unsigned*)(vdst + (bufi) * 16384 + 8192), 16, 0, 0); } while (0)
    const LAS float* btab = (const LAS float*)(lds + AT_BT);
    const float bc_pos = btab[256 + 128], bc_neg = btab[256 - 128];
    int ko[4];
#pragma unroll
    for (int ks = 0; ks < 4; ++ks) ko[ks] = ql * 128 + (((2 * ks + hi) ^ ((ql >> 1) & 7)) << 4);
    const int qrow0 = qb * 256 + wave * 32;
#define AT_SB() __builtin_amdgcn_sched_barrier(0)
    float m_ref = 0.f, l_run = 0.f;
    for (int attempt = 0; attempt < 6; ++attempt) {
    int il = tid; asm volatile("" : "+v"(il)); il &= 63;
    const int sR = 8 * wave + (il >> 3), scl = (il & 7) ^ ((sR >> 1) & 7);
    const bf16_t* kg = Kb + (size_t)(b * SEQ + ((sR & 32) | swap23(sR & 31))) * 512 + h * 128 + c * 64 + 8 * scl;
    const bf16_t* vg0 = VT + (size_t)(h * 128 + sR) * MTOK + b * SEQ + 8 * scl;
    const bf16_t* vg1 = vg0 + (size_t)64 * MTOK;
    LAS unsigned char* kdst = lds + AT_KS + 1024 * wave;
    LAS unsigned char* vdst = lds + AT_VS + 1024 * wave;
    { float zo = 0.f; asm volatile("" : "+v"(zo));
#pragma unroll
      for (int dt = 0; dt < 4; ++dt)
#pragma unroll
          for (int r = 0; r < 16; ++r) O[dt][r] = zo; }
    l_run = 0.f;
    __syncthreads();
    if (use_pin && attempt == 0) {
        (void)pin;
        asm volatile("s_waitcnt vmcnt(0)" ::: "memory");
    } else {
        AT_DMA_K(0, 0); AT_DMA_K(1, 1);
        const bf16_t* qp = Qb + (size_t)(b * SEQ + qpos) * 512 + h * 128 + c * 64 + 8 * hi;
#pragma unroll
        for (int ks = 0; ks < 4; ++ks) *(LAS bf16x8*)(qslot + ks * 1024) = *(const bf16x8*)(qp + 16 * ks); }
    __syncthreads();
    f32x16 Sa0, Sa1, Sb0, Sb1;
    { bf16x8 kf[8], Qf[4];
      const LAS unsigned char* Ks = lds + AT_KS;
#pragma unroll
      for (int ks = 0; ks < 4; ++ks) { Qf[ks] = *(const LAS bf16x8*)(qslot + ks * 1024); kf[2 * ks] = *(const LAS bf16x8*)(Ks + ko[ks]); kf[2 * ks + 1] = *(const LAS bf16x8*)(Ks + 4096 + ko[ks]); }
      const int rel_lo = -(qrow0 + 31), rel_hi = 63 - qrow0;
      float bc = (rel_lo >= 91 ? bc_pos : (rel_hi <= -91 ? bc_neg : 0.f)); asm volatile("" : "+v"(bc));
#pragma unroll
      for (int r = 0; r < 16; ++r) { Sa0[r] = bc; Sa1[r] = bc; }
#pragma unroll
      for (int ks = 0; ks < 4; ++ks) {
          Sa0 = __builtin_amdgcn_mfma_f32_32x32x16_bf16(kf[2 * ks], Qf[ks], Sa0, 0, 0, 0);
          Sa1 = __builtin_amdgcn_mfma_f32_32x32x16_bf16(kf[2 * ks + 1], Qf[ks], Sa1, 0, 0, 0); }
      AT_SB();
      if (!(rel_lo >= 91 || rel_hi <= -91)) {
          const LAS float* bp = btab + (8 * hi - qpos + 256);
#pragma unroll
          for (int r = 0; r < 16; ++r) { Sa0[r] += bp[(r & 7) + 16 * (r >> 3)]; Sa1[r] += bp[32 + (r & 7) + 16 * (r >> 3)]; } }
      if (attempt == 0) {
          float mt = fmaxf(Sa0[0], Sa1[0]);
#pragma unroll
          for (int r = 1; r < 16; ++r) mt = fmaxf(mt, fmaxf(Sa0[r], Sa1[r]));
          { const auto rr = __builtin_amdgcn_permlane32_swap(__float_as_uint(mt), __float_as_uint(mt), false, false); mt = fmaxf(__uint_as_float(rr[0]), __uint_as_float(rr[1])); }
          m_ref = mt; }
#pragma unroll
      for (int r = 0; r < 16; ++r) { Sa0[r] -= m_ref; Sa1[r] -= m_ref; } }
    __syncthreads();
    bf16x8 Pf[4];
#define AT_DMAS(t, QK) do { if (QK) { const int tk = ((t) + 2 < 32 ? (t) + 2 : 31) * tmul; AT_DMA_K(tk, (t) & 1); }     \
        AT_DMA_V((t) * tmul, (t) & 1); } while (0)
#define AT_BIAS(t, C0, C1) do { const int rel_lo = (t) * 64 - (qrow0 + 31), rel_hi = (t) * 64 + 63 - qrow0; \
        if ((t) > 0 && !(rel_lo >= 91 || rel_hi <= -91)) {   \
            const LAS float* bp = btab + ((t) * 64 + 8 * hi - qpos + 256); \
            _Pragma("unroll") for (int r = 0; r < 16; ++r) { C0[r] += bp[(r & 7) + 16 * (r >> 3)]; C1[r] += bp[32 + (r & 7) + 16 * (r >> 3)]; } } } while (0)
#define AT_CINIT(tt, N0, N1) do { const int rel_lo = (tt) * 64 - (qrow0 + 31), rel_hi = (tt) * 64 + 63 - qrow0; \
        float bp_ = bc_pos, bn_ = bc_neg; asm volatile("" : "+v"(bp_), "+v"(bn_));     \
        const float cinit = (rel_lo >= 91 ? bp_ : (rel_hi <= -91 ? bn_ : 0.f)) - m_ref; \
        _Pragma("unroll") for (int r = 0; r < 16; ++r) { N0[r] = cinit; N1[r] = cinit; } } while (0)
#define AT_SOFT(C0, C1, P) do { float ps = 0.f; u32x4 w; \
        _Pragma("unroll") for (int r = 0; r < 16; ++r) { C0[r] = __builtin_amdgcn_exp2f(C0[r]); ps += C0[r]; } \
        _Pragma("unroll") for (int r = 0; r < 16; ++r) { C1[r] = __builtin_amdgcn_exp2f(C1[r]); ps += C1[r]; } \
        w.x = cvt_pk_bf16(C0[0], C0[1]); w.y = cvt_pk_bf16(C0[2], C0[3]); w.z = cvt_pk_bf16(C0[4], C0[5]); w.w = cvt_pk_bf16(C0[6], C0[7]); P[0] = __builtin_bit_cast(bf16x8, w); \
        w.x = cvt_pk_bf16(C0[8], C0[9]); w.y = cvt_pk_bf16(C0[10], C0[11]); w.z = cvt_pk_bf16(C0[12], C0[13]); w.w = cvt_pk_bf16(C0[14], C0[15]); P[1] = __builtin_bit_cast(bf16x8, w); \
        w.x = cvt_pk_bf16(C1[0], C1[1]); w.y = cvt_pk_bf16(C1[2], C1[3]); w.z = cvt_pk_bf16(C1[4], C1[5]); w.w = cvt_pk_bf16(C1[6], C1[7]); P[2] = __builtin_bit_cast(bf16x8, w); \
        w.x = cvt_pk_bf16(C1[8], C1[9]); w.y = cvt_pk_bf16(C1[10], C1[11]); w.z = cvt_pk_bf16(C1[12], C1[13]); w.w = cvt_pk_bf16(C1[14], C1[15]); P[3] = __builtin_bit_cast(bf16x8, w); \
        l_run += ps; asm volatile("" : "+v"(l_run)); } while (0)
#define AT_VLOAD(t, PV) do { if (PV) { const LAS unsigned char* Vs = lds + AT_VS + (((t) + 1) & 1) * 16384; \
        _Pragma("unroll") for (int dt = 0; dt < 4; ++dt) vA[dt] = *(const LAS bf16x8*)(Vs + dt * 4096 + ko[0]); \
        _Pragma("unroll") for (int dt = 0; dt < 4; ++dt) vB[dt] = *(const LAS bf16x8*)(Vs + dt * 4096 + ko[1]); \
        _Pragma("unroll") for (int dt = 0; dt < 4; ++dt) vC[dt] = *(const LAS bf16x8*)(Vs + dt * 4096 + ko[2]); } } while (0)
#define AT_MMA(t, P, N0, N1, PV, QK) do { \
        const LAS unsigned char* Vs = lds + AT_VS + (((t) + 1) & 1) * 16384; \
        const LAS unsigned char* Ks = lds + AT_KS + (((t) + 1) & 1) * 8192; \
        AT_SB(); \
        if (PV) { _Pragma("unroll") for (int dt = 0; dt < 4; ++dt) O[dt] = __builtin_amdgcn_mfma_f32_32x32x16_bf16(vA[dt], P[0], O[dt], 0, 0, 0); \
                  _Pragma("unroll") for (int dt = 0; dt < 4; ++dt) vA[dt] = *(const LAS bf16x8*)(Vs + dt * 4096 + ko[3]); } \
        if (QK) { _Pragma("unroll") for (int ks = 0; ks < 2; ++ks) { kf[2 * ks] = *(const LAS bf16x8*)(Ks + ko[ks]); kf[2 * ks + 1] = *(const LAS bf16x8*)(Ks + 4096 + ko[ks]); } } \
        AT_SB(); \
        if (PV) { _Pragma("unroll") for (int dt = 0; dt < 4; ++dt) O[dt] = __builtin_amdgcn_mfma_f32_32x32x16_bf16(vB[dt], P[1], O[dt], 0, 0, 0); } \
        if (QK) { _Pragma("unroll") for (int ks = 2; ks < 4; ++ks) { kf[2 * ks] = *(const LAS bf16x8*)(Ks + ko[ks]); kf[2 * ks + 1] = *(const LAS bf16x8*)(Ks + 4096 + ko[ks]); } } \
        AT_SB(); \
        if (PV) { _Pragma("unroll") for (int dt = 0; dt < 4; ++dt) O[dt] = __builtin_amdgcn_mfma_f32_32x32x16_bf16(vC[dt], P[2], O[dt], 0, 0, 0); } \
        if (QK) { _Pragma("unroll") for (int ks = 0; ks < 4; ++ks) Qf[ks] = *(const LAS bf16x8*)(qslot + ks * 1024); } \
        AT_SB(); \
        if (PV) { _Pragma("unroll") for (int dt = 0; dt < 4; ++dt) O[dt] = __builtin_amdgcn_mfma_f32_32x32x16_bf16(vA[dt], P[3], O[dt], 0, 0, 0); } \
        AT_SB(); \
        if (QK) { _Pragma("unroll") for (int ks = 0; ks < 4; ++ks) { \
                N0 = __builtin_amdgcn_mfma_f32_32x32x16_bf16(kf[2 * ks], Qf[ks], N0, 0, 0, 0); \
                N1 = __builtin_amdgcn_mfma_f32_32x32x16_bf16(kf[2 * ks + 1], Qf[ks], N1, 0, 0, 0); } } \
        AT_SB(); } while (0)
#define AT_ITER_A(t, C0, C1, N0, N1, PV, QK) do { bf16x8 vA[4], vB[4], vC[4], kf[8], Qf[4]; \
        AT_DMAS(t, QK); AT_VLOAD(t, PV); AT_MMA(t, Pf, N0, N1, PV, QK); \
        AT_BIAS(t, C0, C1); AT_SOFT(C0, C1, Pf); if ((t) + 2 < 32) AT_CINIT((t) + 2, C0, C1); AT_SB(); \
        __syncthreads(); } while (0)
#define AT_ITER_B(t, C0, C1, N0, N1, PV, QK) do { bf16x8 vA[4], vB[4], vC[4], kf[8], Qf[4], Pn[4]; \
        AT_DMAS(t, QK); \
        AT_BIAS(t, C0, C1); AT_SOFT(C0, C1, Pn); if (QK) AT_CINIT((t) + 1, N0, N1); AT_SB(); \
        AT_VLOAD(t, PV); AT_MMA(t, Pf, N0, N1, PV, QK); \
        _Pragma("unroll") for (int i_ = 0; i_ < 4; ++i_) Pf[i_] = Pn[i_]; \
        __syncthreads(); } while (0)
    if (wave < 4) {
        AT_CINIT(1, Sb0, Sb1);
        AT_ITER_A(0, Sa0, Sa1, Sb0, Sb1, 0, 1);
#pragma unroll 1
        for (int t2 = 1; t2 < 31; t2 += 2) {
            AT_ITER_A(t2, Sb0, Sb1, Sa0, Sa1, 1, 1);
            AT_ITER_A(t2 + 1, Sa0, Sa1, Sb0, Sb1, 1, 1);
        }
        AT_ITER_A(31, Sb0, Sb1, Sa0, Sa1, 1, 0);
    } else {
        AT_ITER_B(0, Sa0, Sa1, Sb0, Sb1, 0, 1);
#pragma unroll 1
        for (int t2 = 1; t2 < 31; t2 += 2) {
            AT_ITER_B(t2, Sb0, Sb1, Sa0, Sa1, 1, 1);
            AT_ITER_B(t2 + 1, Sa0, Sa1, Sb0, Sb1, 1, 1);
        }
        AT_ITER_B(31, Sb0, Sb1, Sa0, Sa1, 1, 0);
    }
#undef AT_ITER_A
#undef AT_ITER_B
#undef AT_MMA
#undef AT_VLOAD
#undef AT_SOFT
#undef AT_CINIT
#undef AT_BIAS
#undef AT_DMAS
    pretail();
    {
        const LAS unsigned char* Vs = lds + AT_VS + 16384;
#pragma unroll
        for (int s2 = 0; s2 < 4; ++s2) {
            bf16x8 vf[4];
#pragma unroll
            for (int dt = 0; dt < 4; ++dt) vf[dt] = *(const LAS bf16x8*)(Vs + dt * 4096 + ko[s2]);
#pragma unroll
            for (int dt = 0; dt < 4; ++dt) O[dt] = __builtin_amdgcn_mfma_f32_32x32x16_bf16(vf[dt], Pf[s2], O[dt], 0, 0, 0);
        }
    }
    if (__all(l_run < 1e30f)) break;
    m_ref += 80.f;
    }
#undef AT_SB
#undef AT_DMA_K
#undef AT_DMA_V
    const float lt = sum_halves(l_run);
    const float inv = __builtin_amdgcn_rcpf(lt);
#pragma unroll
    for (int dt = 0; dt < 4; ++dt)
#pragma unroll
        for (int r = 0; r < 16; ++r) O[dt][r] *= inv;
}
__device__ __forceinline__ void attn_unit(const Args& a, int l, LAS unsigned char* lds, int L, const bool build_tab, float lam, float lam_init, int wave, int lane, int tid, bf16_t* Yout, const int pmode) {
    unsigned char* ws = kws();
    tid = rebuild_tid(wave); lane = tid & 63;
    bf16_t* Qb = (bf16_t*)(ws + WS_Q); const bf16_t* Kb = (const bf16_t*)(ws + WS_K); const bf16_t* VT = (const bf16_t*)(ws + WS_UT); const bf16_t* ZA = (const bf16_t*)(ws + WS_ZA);
    const int x = L & 7, jj = L >> 3, bh = x + 8 * (jj >> 3), qb = jj & 7, b = bh >> 2, h = bh & 3;
    if (build_tab) {
    __syncthreads();
    { int tt = tid; asm volatile("" : "+v"(tt));
      { const int rel = tt - 256; ((LAS float*)(lds + AT_BT))[tt] = kin(I_RELB)[t5_bucket(rel) * 4 + h] * LOG2E; }
      if (tt < 128) ((LAS float*)(lds + AT_SL))[tt] = kin(I_SUBLN)[(size_t)l * 128 + tt]; }
    __syncthreads(); }
    f32x16 O[4];
    APre pre;
    attn_pass(lds, Qb, Kb, VT, b, h, 0, qb, wave, lane, tid, O, pmode, pre, false, [&] { attn_prefetch(pre, lds, Qb, Kb, b, h, 1, qb, wave, tid); });
    int tls = tid; asm volatile("" : "+v"(tls));
    LAS unsigned* stash = (LAS unsigned*)(lds + AT_ST) + wave * 2048 + (tls & 63);
#pragma unroll
    for (int dt = 0; dt < 4; ++dt)
#pragma unroll
        for (int r = 0; r < 8; ++r) stash[(dt * 8 + r) * 64] = cvt_pk_bf16(O[dt][2 * r], O[dt][2 * r + 1]);
    u32x2 zw[16];
    attn_pass(lds, Qb, Kb, VT, b, h, 1, qb, wave, lane, tid, O, pmode, pre, true, [&] {
        int tl = tid; asm volatile("" : "+v"(tl)); const int ln = tl & 63, ql_ = ln & 31, hi_ = ln >> 5;
        const size_t tok_ = (size_t)b * SEQ + qb * 256 + wave * 32 + ql_;
#pragma unroll
        for (int dt = 0; dt < 4; ++dt)
#pragma unroll
            for (int rg = 0; rg < 4; ++rg) zw[dt * 4 + rg] = *(const u32x2*)(ZA + tok_ * 512 + h * 128 + 32 * dt + 8 * rg + 4 * hi_); });
    float ss = 0.f;
#pragma unroll
    for (int dt = 0; dt < 4; ++dt)
#pragma unroll
        for (int r = 0; r < 8; ++r) { const unsigned p0 = stash[(dt * 8 + r) * 64]; const float o0 = bf_lo(p0) - lam * O[dt][2 * r], o1 = bf_hi(p0) - lam * O[dt][2 * r + 1];
            O[dt][2 * r] = o0; O[dt][2 * r + 1] = o1; ss += o0 * o0 + o1 * o1; }
    ss = sum_halves(ss);
    const float rn = __builtin_amdgcn_rsqf(ss * (1.0f / 128.0f) + 1e-5f) * __uint_as_float(__builtin_amdgcn_readfirstlane(__float_as_uint(1.0f - lam_init)));
    { int tl = tid; asm volatile("" : "+v"(tl)); lane = tl & 63; }
    const int ql = lane & 31, hi = lane >> 5;
    const size_t tok = (size_t)b * SEQ + qb * 256 + wave * 32 + ql;
    const LAS float* subl = (const LAS float*)(lds + AT_SL);
#pragma unroll
    for (int dt = 0; dt < 4; ++dt)
#pragma unroll
        for (int rg = 0; rg < 4; ++rg) {
            const int dvb = 32 * dt + 8 * rg + 4 * hi;
            const f32x4 sg = *(const LAS f32x4*)(subl + dvb);
            const u32x2 zv = zw[dt * 4 + rg];
            const float z0 = bf_lo(zv.x), z1 = bf_hi(zv.x), z2 = bf_lo(zv.y), z3 = bf_hi(zv.y);
            const float y0 = O[dt][4 * rg + 0] * rn * sg[0] * z0 * fast_sigmoid(z0);
            const float y1 = O[dt][4 * rg + 1] * rn * sg[1] * z1 * fast_sigmoid(z1);
            const float y2 = O[dt][4 * rg + 2] * rn * sg[2] * z2 * fast_sigmoid(z2);
            const float y3 = O[dt][4 * rg + 3] * rn * sg[3] * z3 * fast_sigmoid(z3);
            u32x2 w; w.x = cvt_pk_bf16(y0, y1); w.y = cvt_pk_bf16(y2, y3);
            *(u32x2*)(Yout + tok * 512 + h * 128 + dvb) = w;
        }
}

constexpr int HY_FP = 8256, HY_UP = 4128;
constexpr int HY_F = 0;
constexpr int HY_U = 8 * HY_FP;
constexpr int HY_G = HY_U + 16 * HY_UP;
static_assert(HY_G + 8192 + 16 <= MISC_OFF, "hyena LDS");

__device__ __forceinline__ void conv4(const bf16_t* rowp, int t, float w0, float w1, float w2, float cb, float (&o)[4]) {
    const u32x2 mid = *(const u32x2*)(rowp + t);
    const float hm = t > 0 ? bf2f(rowp[t - 1]) : 0.f, hp = (t + 4 < SEQ) ? bf2f(rowp[t + 4]) : 0.f;
    const float h0 = bf_lo(mid.x), h1 = bf_hi(mid.x), h2 = bf_lo(mid.y), h3 = bf_hi(mid.y);
    o[0] = w0 * hm + w1 * h0 + w2 * h1 + cb; o[1] = w0 * h0 + w1 * h1 + w2 * h2 + cb; o[2] = w0 * h1 + w1 * h2 + w2 * h3 + cb; o[3] = w0 * h2 + w1 * h3 + w2 * hp + cb;
}
__device__ __forceinline__ void hy_build_copies(LAS unsigned char* lds, int tid) {
    const u32x4 A = *(const LAS u32x4*)(lds + HY_G + 16 * tid), B = *(const LAS u32x4*)(lds + HY_G + 16 * tid + 16);
    const unsigned cat[8] = {A.x, A.y, A.z, A.w, B.x, B.y, B.z, B.w};
#pragma unroll
    for (int k = 0; k < 8; ++k) { const int s = k + 1; u32x4 o;
        if ((s & 1) == 0) { o.x = cat[s / 2]; o.y = cat[s / 2 + 1]; o.z = cat[s / 2 + 2]; o.w = cat[s / 2 + 3]; }
        else { const int lo = (s - 1) / 2;
            o.x = __builtin_amdgcn_alignbit(cat[lo + 1], cat[lo], 16); o.y = __builtin_amdgcn_alignbit(cat[lo + 2], cat[lo + 1], 16);
            o.z = __builtin_amdgcn_alignbit(cat[lo + 3], cat[lo + 2], 16); o.w = __builtin_amdgcn_alignbit(cat[lo + 4], cat[lo + 3], 16); }
        *(LAS u32x4*)(lds + HY_F + k * HY_FP + 16 * tid) = o; }
}
__device__ __forceinline__ void hy_mfma(const LAS unsigned char* lds, int wave, int lane, f32x4 (&acc)[16], const int msteps) {
    const int i = lane & 15, g = lane >> 4;
    const LAS unsigned char* fb = lds + HY_F + (i & 7) * HY_FP + 2 * ((i & 8) + 8 * g) + 32 * (16 * wave);
    const LAS unsigned char* ub = lds + HY_U + i * HY_UP + 16 * g;
    bf16x8 Aw[16];
    float zf = 0.f; asm volatile("" : "+v"(zf));
#pragma unroll
    for (int tb = 0; tb < 16; ++tb) { acc[tb] = (f32x4){zf, zf, zf, zf}; Aw[tb] = *(const LAS bf16x8*)(fb + 32 * tb); }
    bf16x8 Bb[2];
    Bb[0] = *(const LAS bf16x8*)(ub);
    for (int mo = 0; mo < msteps; mo += 8) {
#pragma unroll
        for (int mi = 0; mi < 8; ++mi) {
            const int m = mo + mi;
            const bf16x8 Bf = Bb[mi & 1];
            acc[0] = __builtin_amdgcn_mfma_f32_16x16x32_bf16(Aw[(0 + 2 * mi) & 15], Bf, acc[0], 0, 0, 0);
            acc[1] = __builtin_amdgcn_mfma_f32_16x16x32_bf16(Aw[(1 + 2 * mi) & 15], Bf, acc[1], 0, 0, 0);
            __builtin_amdgcn_sched_barrier(0);
            Aw[(2 * mi) & 15] = *(const LAS bf16x8*)(fb + 32 * (16 + 2 * m));
            Aw[(2 * mi + 1) & 15] = *(const LAS bf16x8*)(fb + 32 * (17 + 2 * m));
            Bb[(mi + 1) & 1] = *(const LAS bf16x8*)(ub + 64 * (m + 1));
            __builtin_amdgcn_sched_barrier(0);
#pragma unroll
            for (int tb = 2; tb < 16; ++tb) acc[tb] = __builtin_amdgcn_mfma_f32_16x16x32_bf16(Aw[(tb + 2 * mi) & 15], Bf, acc[tb], 0, 0, 0);
            __builtin_amdgcn_sched_barrier(0);
        }
    }
}
__device__ __forceinline__ void hyena_unit(const Args& a, int l, LAS unsigned char* lds, int c, int wave, int lane, int tid, bf16_t* YTbase, const int msteps) {
    unsigned char* ws = kws();
    const bf16_t* FT = (const bf16_t*)(ws + WS_FT) + (size_t)l * (2 * 512 * 4096);
    bf16_t* UT = (bf16_t*)(ws + WS_UT);
    const bf16_t* HV = UT + (size_t)(512 + c) * MTOK; const bf16_t* HX1 = UT + (size_t)(1024 + c) * MTOK; const bf16_t* HX2 = UT + (size_t)(1536 + c) * MTOK; const bf16_t* ZH = UT + (size_t)(2048 + c) * MTOK;
    bf16_t* YT = YTbase + (size_t)c * MTOK;
    const float* cw = kin(I_CW) + (size_t)l * 3 * 1536; const float* cb = kin(I_CB) + (size_t)l * 1536;
    const float wv0 = cw[c], wv1 = cw[1536 + c], wv2 = cw[3072 + c], bv = cb[c];
    const float wa0 = cw[512 + c], wa1 = cw[1536 + 512 + c], wa2 = cw[3072 + 512 + c], ba = cb[512 + c];
    const float wb0 = cw[1024 + c], wb1 = cw[1536 + 1024 + c], wb2 = cw[3072 + 1024 + c], bb = cb[1024 + c];
    __syncthreads();
    *(LAS u32x4*)(lds + HY_G + 16 * tid) = *(const u32x4*)(FT + (size_t)(0 * 512 + c) * 4096 + 8 * tid);
    { unsigned zz = 0u; asm volatile("" : "+v"(zz));
      if (tid == 0) *(LAS u32x4*)(lds + HY_G + 8192) = (u32x4){zz, zz, zz, zz}; }
    {
      u32x4 hv8[8]; bf16_t hl[8], hr[8];
#pragma unroll
      for (int it = 0; it < 8; ++it) { const int task = it * NTHR + tid, jc = task & 255, b = task >> 8; const bf16_t* rowp = HV + (size_t)b * SEQ; const int s0 = 8 * jc;
          hv8[it] = *(const u32x4*)(rowp + s0); hl[it] = rowp[s0 > 0 ? s0 - 1 : 0]; hr[it] = rowp[s0 + 8 < SEQ ? s0 + 8 : SEQ - 1]; }
#pragma unroll
      for (int it = 0; it < 8; ++it) { const int task = it * NTHR + tid, jc = task & 255, b = task >> 8; const int s0 = 8 * jc;
          float h[10]; h[0] = s0 > 0 ? bf2f(hl[it]) : 0.f; h[9] = (s0 + 8 < SEQ) ? bf2f(hr[it]) : 0.f;
          h[1] = bf_lo(hv8[it].x); h[2] = bf_hi(hv8[it].x); h[3] = bf_lo(hv8[it].y); h[4] = bf_hi(hv8[it].y); h[5] = bf_lo(hv8[it].z); h[6] = bf_hi(hv8[it].z); h[7] = bf_lo(hv8[it].w); h[8] = bf_hi(hv8[it].w);
          float v[8];
#pragma unroll
          for (int e = 0; e < 8; ++e) v[e] = wv0 * h[e] + wv1 * h[e + 1] + wv2 * h[e + 2] + bv;
          u32x4 w; w.x = cvt_pk_bf16(v[7], v[6]); w.y = cvt_pk_bf16(v[5], v[4]); w.z = cvt_pk_bf16(v[3], v[2]); w.w = cvt_pk_bf16(v[1], v[0]);
          *(LAS u32x4*)(lds + HY_U + b * HY_UP + (2040 - s0) * 2) = w; } }
    __syncthreads();
    hy_build_copies(lds, tid);
    __syncthreads();
    attn_glds(FT + (size_t)(1 * 512 + c) * 4096 + 8 * tid, (unsigned)(size_t)lds + HY_G + 1024 * wave);
    f32x4 acc[16];
    const int bcol = lane & 15;
    u32x2 xm[16];
    { int g4 = lane >> 4; asm volatile("" : "+v"(g4)); const bf16_t* rowp = HX1 + (size_t)bcol * SEQ;
#pragma unroll
      for (int tb = 0; tb < 16; ++tb) xm[tb] = *(const u32x2*)(rowp + 256 * wave + 16 * tb + 4 * g4); }
    hy_mfma(lds, wave, lane, acc, msteps);
    asm volatile("s_waitcnt vmcnt(0)" ::: "memory");
    __syncthreads();
    hy_build_copies(lds, tid);
    { int g4 = lane >> 4; asm volatile("" : "+v"(g4));
      const bf16_t* rowp = HX1 + (size_t)bcol * SEQ;
      bf16_t xl[16], xr[16];
#pragma unroll
      for (int tb = 0; tb < 16; ++tb) { const int t = 256 * wave + 16 * tb + 4 * g4;
          xl[tb] = rowp[t > 0 ? t - 1 : 0]; xr[tb] = rowp[t + 4 < SEQ ? t + 4 : SEQ - 1]; }
#pragma unroll
      for (int tb = 0; tb < 16; ++tb) { const int t = 256 * wave + 16 * tb + 4 * g4;
          const float hm = t > 0 ? bf2f(xl[tb]) : 0.f, hp = (t + 4 < SEQ) ? bf2f(xr[tb]) : 0.f, h0 = bf_lo(xm[tb].x), h1 = bf_hi(xm[tb].x), h2 = bf_lo(xm[tb].y), h3 = bf_hi(xm[tb].y);
          const float x0 = wa0 * hm + wa1 * h0 + wa2 * h1 + ba, x1 = wa0 * h0 + wa1 * h1 + wa2 * h2 + ba, x2 = wa0 * h1 + wa1 * h2 + wa2 * h3 + ba, x3 = wa0 * h2 + wa1 * h3 + wa2 * hp + ba;
          u32x2 w; w.x = cvt_pk_bf16(acc[tb][3] * x3, acc[tb][2] * x2); w.y = cvt_pk_bf16(acc[tb][1] * x1, acc[tb][0] * x0);
          *(LAS u32x2*)(lds + HY_U + bcol * HY_UP + (2044 - t) * 2) = w; } }
    __syncthreads();
    { int g4 = lane >> 4; asm volatile("" : "+v"(g4)); const bf16_t* rowp = HX2 + (size_t)bcol * SEQ;
#pragma unroll
      for (int tb = 0; tb < 16; ++tb) xm[tb] = *(const u32x2*)(rowp + 256 * wave + 16 * tb + 4 * g4); }
    u32x2 zv[16];
    { int g4 = lane >> 4; asm volatile("" : "+v"(g4)); const bf16_t* zrow = ZH + (size_t)bcol * SEQ;
#pragma unroll
      for (int tb = 0; tb < 16; ++tb) zv[tb] = *(const u32x2*)(zrow + 256 * wave + 16 * tb + 4 * g4); }
    hy_mfma(lds, wave, lane, acc, msteps);
    { int g4 = lane >> 4; asm volatile("" : "+v"(g4));
      const bf16_t* rowp = HX2 + (size_t)bcol * SEQ; bf16_t* yrow = YT + (size_t)bcol * SEQ;
      bf16_t xl[16], xr[16];
#pragma unroll
      for (int tb = 0; tb < 16; ++tb) { const int t = 256 * wave + 16 * tb + 4 * g4;
          xl[tb] = rowp[t > 0 ? t - 1 : 0]; xr[tb] = rowp[t + 4 < SEQ ? t + 4 : SEQ - 1]; }
#pragma unroll
      for (int tb = 0; tb < 16; ++tb) { const int t = 256 * wave + 16 * tb + 4 * g4;
          const float hm = t > 0 ? bf2f(xl[tb]) : 0.f, hp = (t + 4 < SEQ) ? bf2f(xr[tb]) : 0.f, h0 = bf_lo(xm[tb].x), h1 = bf_hi(xm[tb].x), h2 = bf_lo(xm[tb].y), h3 = bf_hi(xm[tb].y);
          const float x0 = wb0 * hm + wb1 * h0 + wb2 * h1 + bb, x1 = wb0 * h0 + wb1 * h1 + wb2 * h2 + bb, x2 = wb0 * h1 + wb1 * h2 + wb2 * h3 + bb, x3 = wb0 * h2 + wb1 * h3 + wb2 * hp + bb;
          const float z0 = bf_lo(zv[tb].x), z1 = bf_hi(zv[tb].x), z2 = bf_lo(zv[tb].y), z3 = bf_hi(zv[tb].y);
          u32x2 w; w.x = cvt_pk_bf16(acc[tb][0] * x0 * z0 * fast_sigmoid(z0), acc[tb][1] * x1 * z1 * fast_sigmoid(z1));
          w.y = cvt_pk_bf16(acc[tb][2] * x2 * z2 * fast_sigmoid(z2), acc[tb][3] * x3 * z3 * fast_sigmoid(z3));
          *(u32x2*)(yrow + t) = w; } }
}

__global__ void __launch_bounds__(NTHR, 2) fwd_kernel(Args args) {
    extern __shared__ __attribute__((aligned(16))) unsigned char lds_raw[];
    LAS unsigned char* lds = (LAS unsigned char*)lds_raw;
    volatile LAS unsigned* MISC = (volatile LAS unsigned*)(lds + MISC_OFF);
    const int G = gridDim.x;
    const int wave_s = __builtin_amdgcn_readfirstlane((int)threadIdx.x >> 6);
    if (threadIdx.x < 64) MISC[threadIdx.x] = 0u;
    __syncthreads();
    const int lo = args.ph_lo, hi = args.ph_hi;
    if (hi - lo > 1) (void)xcd_barrier_post((unsigned*)(kws() + WS_CTL), MISC + 8);
#ifndef PHASE_MASK
#define PHASE_MASK 0x7f
#endif
#define EN(j) ((PHASE_MASK >> (j)) & 1)
#define IN(k) (lo <= (k) && (k) < hi)
#define SEAM(k) do { if (IN(k) && IN((k) + 1)) { XcdBarrier bl; bl.bar = (unsigned*)(kws() + WS_CTL); bl.x = xb_xcc_id(); bl.st = MISC + 8; xcd_barrier(bl); if (PROBE_DUP & 1024) xcd_barrier(bl); } } while (0)
#define PHASE_IDS() int wave = wave_s; asm volatile("" : "+s"(wave)); unsigned ones_ = ~0u; asm volatile("" : "+s"(ones_)); int tid = wave * 64 + (int)__builtin_amdgcn_mbcnt_hi(ones_, __builtin_amdgcn_mbcnt_lo(ones_, 0u)); asm volatile("" : "+v"(tid)); int bid = blockIdx.x; asm volatile("" : "+s"(bid)); const int lane = tid & 63; const int gw = bid * NWAVES + wave, NGW = G * NWAVES; (void)gw; (void)NGW; (void)lane

#define RELAUNDER() asm volatile("" : "+v"(tid))
    if (EN(0) && IN(0)) {
        PHASE_IDS();
        if (tid == 0) __hip_atomic_store((unsigned*)(kws() + WS_CTL) + XTAB_WORD0 + bid, xb_xcc_id() + 1u, __ATOMIC_RELAXED, __HIP_MEMORY_SCOPE_AGENT);
        norm_rows(args, 0, gw, MTOK, NGW, lane);
        convert_weights(args, 0, lds, gw, NGW, wave, lane);
        for (int u = bid; u < DEPTH * 64; u += G) make_filters(args, u >> 6, lds, u & 63, tid);
    }
    SEAM(0);
    for (int l = 0; l < DEPTH; ++l) {
        const int pb0 = 1 + 3 * l;
        if (EN(1) && IN(pb0 + 0)) {
            PHASE_IDS();
            __syncthreads();
            { pg8::Gemm g{(const bf16_t*)(kws() + WS_XB), (const bf16_t*)(kws() + WS_WA1), MTOK, NA1, DM}; pg8::StaticOrder S; S.init(MTOK, NA1, G, bid, (PROBE_DUP & 1) ? 2 : 1);
              pg8::EpiA1 E{(const float*)(kws() + WS_RS), (bf16_t*)(kws() + WS_Q), (bf16_t*)(kws() + WS_K), (bf16_t*)(kws() + WS_ZA), (bf16_t*)(kws() + WS_GA), (bf16_t*)(kws() + WS_GH)};
              pg8::gemm_phase<pg8::EpiA1, pg8::StaticOrder>(lds, g, S, E, tid); }
            { pg8::Gemm g{(const bf16_t*)(kws() + WS_WA2), (const bf16_t*)(kws() + WS_XB), NA2, MTOK, DM}; pg8::StaticOrder S; S.init(NA2, MTOK, G, bid, (PROBE_DUP & 2) ? 2 : 1);
              pg8::EpiA2 E{(const float*)(kws() + WS_RS), (bf16_t*)(kws() + WS_UT)};
              pg8::gemm_phase<pg8::EpiA2, pg8::StaticOrder>(lds, g, S, E, tid); }
        }
        SEAM(pb0 + 0);
        if (EN(2) && IN(pb0 + 1)) {
            PHASE_IDS();
            const float lam_init = __uint_as_float(__builtin_amdgcn_readfirstlane(__float_as_uint(l == 0 ? 0.2f : (l == 1 ? 0.35550906759f : (l == 2 ? 0.47071301834f : 0.55605820410f)))));
            const float d1 = wave_sum(kin(I_LQ1)[l * 64 + lane] * kin(I_LK1)[l * 64 + lane], lane);
            const float d2 = wave_sum(kin(I_LQ2)[l * 64 + lane] * kin(I_LK2)[l * 64 + lane], lane);
            const float lam = __uint_as_float(__builtin_amdgcn_readfirstlane(__float_as_uint(__builtin_amdgcn_exp2f(d1 * LOG2E) - __builtin_amdgcn_exp2f(d2 * LOG2E) + lam_init)));
            { constexpr int AREP = (PROBE_DUP & 4) ? 2 : 1, HREP = (PROBE_DUP & 8) ? 2 : 1;
              { int hprev = -1;
                for (int L = bid; L < 512; L += G) { const int hh = ((L & 7) + 8 * (L >> 6)) & 3; attn_unit(args, l, lds, L, hh != hprev, lam, lam_init, wave, lane, tid, (bf16_t*)(kws() + WS_Q), 0); hprev = hh; } }
              tid = rebuild_tid(wave);
              for (int c = bid; c < 512 * HREP; c += G) hyena_unit(args, l, lds, c & 511, wave, tid & 63, tid, (c < 512 * (HREP - 1)) ? (bf16_t*)kout() : (bf16_t*)(kws() + WS_UT + (size_t)512 * MTOK * 2), (c < 512 * (HREP - 1) && (PROBE_MODE & 4)) ? 32 : 64); }
        }
        SEAM(pb0 + 1);
        if (EN(3) && IN(pb0 + 2)) {
            PHASE_IDS();
            unsigned* ctl = (unsigned*)(kws() + WS_CTL);
            pg8::StaticOrder SO; SO.init(MTOK, DM, G, bid); pg8::Unit u0; SO.next(0, u0);
            const int P0 = u0.pm, qm = u0.pn;
            const int myp = qm < 2 ? P0 : P0 + 8, myh = qm & 1;
            const size_t cset = (size_t)(l & 1) * WS_WC2;
            bool samex = true;
            const unsigned sx_ = (unsigned)__builtin_amdgcn_readfirstlane((int)MISC[12]);
            if (sx_ != 0u) samex = sx_ == 2u;
            else {
              unsigned xs[4]; const unsigned mine = xb_ld(ctl + XTAB_WORD0 + bid);
#pragma unroll
              for (int j = 0; j < 4; ++j) xs[j] = xb_ld(ctl + XTAB_WORD0 + ((bid & ~96) | (j << 5)));
#pragma unroll
              for (int j = 0; j < 4; ++j) { const int cj = (bid & ~96) | (j << 5); pg8::StaticOrder Sj; Sj.init(MTOK, DM, G, cj); pg8::Unit uj; const bool okj = Sj.next(0, uj) && uj.pm == P0;
                  samex = samex && okj && xs[j] == mine && xs[j] != 0u; }
              samex = __builtin_amdgcn_readfirstlane((int)samex) != 0;
              __syncthreads(); if (tid == 0) MISC[12] = samex ? 2u : 1u; }
            if (bid < 256) {
            { pg8::Gemm g{(const bf16_t*)(kws() + WS_Q), (const bf16_t*)(kws() + WS_WPA + cset), MTOK, DM, 512}; pg8::StaticOrder S; S.init(MTOK, DM, G, bid);
              pg8::EpiC1a E{(bf16_t*)(kws() + WS_GA), (bf16_t*)(kws() + WS_GA)};
              pg8::gemm_phase<pg8::EpiC1a, pg8::StaticOrder>(lds, g, S, E, tid); }
            RELAUNDER();
            { pg8::Gemm g{(const bf16_t*)(kws() + WS_UT + (size_t)512 * MTOK * 2), (const bf16_t*)(kws() + WS_WPH + cset), MTOK, DM, 512}; pg8::StaticOrder S; S.init(MTOK, DM, G, bid);
              pg8::EpiC1b E{(const bf16_t*)(kws() + WS_GA), (const bf16_t*)(kws() + WS_GH), (bf16_t*)(kws() + WS_GA)};
              pg8::gemm_phase<pg8::EpiC1b, pg8::StaticOrder, true, true, true>(lds, g, S, E, tid); }
            pair_post(ctl + pc_word(l, 1, P0), samex, tid);
            pair_wait(ctl, ctl + pc_word(l, 1, P0), 4u, tid);
            RELAUNDER();
            { pg8::Gemm g{(const bf16_t*)(kws() + WS_GA), (const bf16_t*)(kws() + WS_WOUT + cset), MTOK, DM, DM}; pg8::StaticOrder S; S.init(MTOK, DM, G, bid);
              pg8::EpiC2 E{(bf16_t*)(kws() + WS_GH), (float*)(kws() + WS_PART)};
              pg8::gemm_phase<pg8::EpiC2, pg8::StaticOrder>(lds, g, S, E, tid); }
            pair_post(ctl + pc_word(l, 2, P0), samex, tid);
            RELAUNDER();
            if (l + 1 < DEPTH) convert_weights(args, l + 1, lds, gw, NGW, wave, tid & 63);
            pair_wait(ctl, ctl + pc_word(l, 2, P0), 4u, tid);
            RELAUNDER();
            norm_rows(args, l + 1, myp * 256 + myh * 128 + wave, myp * 256 + myh * 128 + 128, NWAVES, tid & 63);
            } else { if (l + 1 < DEPTH) convert_weights(args, l + 1, lds, gw, NGW, wave, tid & 63); }
        }
        SEAM(pb0 + 2);
    }
#undef IN
#undef SEAM
}

#ifndef MK_PER_PHASE
#define MK_PER_PHASE 0
#endif
extern "C" void kernel_launch(void* const* d_in, const int* in_sizes, int n_in, void* d_out, int out_size, void* d_ws, size_t ws_size, hipStream_t stream) {
    static int grid = 0;
    if (grid == 0) {
        if (n_in != N_IN || out_size != MTOK * DM || ws_size < WS_END) { fprintf(stderr, "kernel_launch: unexpected shapes (n_in %d, out %d, ws %zu)\n", n_in, out_size, ws_size); grid = -1; return; }
        int dev = 0, cus = 0, per_cu = 0;
        if (hipGetDevice(&dev) != hipSuccess || hipDeviceGetAttribute(&cus, hipDeviceAttributeMultiprocessorCount, dev) != hipSuccess) { grid = -1; return; }
        if (hipFuncSetAttribute((const void*)fwd_kernel, hipFuncAttributeMaxDynamicSharedMemorySize, LDS_BYTES) != hipSuccess) { fprintf(stderr, "kernel_launch: hipFuncSetAttribute failed\n"); grid = -1; return; }
        if (hipOccupancyMaxActiveBlocksPerMultiprocessor(&per_cu, (const void*)fwd_kernel, NTHR, LDS_BYTES) != hipSuccess || per_cu < 1) fprintf(stderr, "kernel_launch: occupancy query reports %d\n", per_cu);
        (void)hipGetLastError();
        if (cus != 256) { fprintf(stderr, "kernel_launch: built for 256 CUs (row-panel pairs in phase C), found %d\n", cus); grid = -1; return; }
        grid = cus;
    }
    if (grid < 0) return;
    (void)hipMemsetAsync((char*)d_ws + WS_CTL, 0, CTL_ZERO_BYTES, stream);
    Args a{};
    for (int i = 0; i < N_IN; ++i) a.in[i] = (const float*)d_in[i];
    a.out = (float*)d_out; a.ws = (unsigned char*)d_ws;
    constexpr int NPH = 1 + 3 * DEPTH;
#if MK_PER_PHASE
    for (int p = 0; p < NPH; ++p) { a.ph_lo = p; a.ph_hi = p + 1; hipLaunchKernelGGL(fwd_kernel, dim3(grid), dim3(NTHR), LDS_BYTES, stream, a); }
#else
    a.ph_lo = 0; a.ph_hi = NPH; hipLaunchKernelGGL(fwd_kernel, dim3(grid), dim3(NTHR), LDS_BYTES, stream, a);
#endif
}
```

```cpp
#include <hip/hip_runtime.h>
#include <cstdio>
#include <cstdint>

#define LAS __attribute__((address_space(3)))
typedef unsigned short bf16_t;
typedef short bf16x8 __attribute__((ext_vector_type(8)));
typedef float f32x4 __attribute__((ext_vector_type(4)));
typedef float f32x16 __attribute__((ext_vector_type(16)));
typedef unsigned u32x4 __attribute__((ext_vector_type(4)));
typedef unsigned u32x2 __attribute__((ext_vector_type(2)));

constexpr int DM = 1024, NBATCH = 16, SEQ = 2048, DEPTH = 4, MTOK = NBATCH * SEQ;
constexpr int WIN = 6144;
constexpr int NA1 = 3584;
constexpr int NA2 = 2560;
constexpr float QSCALE = 0.125f * 1.4426950408889634f;
constexpr float LOG2E = 1.4426950408889634f;
constexpr int NWAVES = 8, NTHR = 512;

constexpr size_t MiB = 1u << 20;
constexpr size_t WS_CTL = 0, CTL_ZERO_BYTES = 256 * 1024;
constexpr int PC_WORD0 = 8192, XTAB_WORD0 = 4096;
__host__ __device__ constexpr int pc_word(int l, int k, int pm) { return PC_WORD0 + ((l * 3 + k) * 128 + pm) * 32; }
constexpr size_t WS_WA1 = 1 * MiB;
constexpr size_t WS_WA2 = 8 * MiB;
constexpr size_t WS_WPA = 13 * MiB;
constexpr size_t WS_WPH = 14 * MiB;
constexpr size_t WS_WOUT = 15 * MiB;
constexpr size_t WS_WC2 = 4 * MiB;
constexpr size_t WS_FT = 476 * MiB;
constexpr size_t WS_RS = 25 * MiB;
constexpr size_t WS_PART = 26 * MiB;
constexpr size_t WS_XB = 28 * MiB;
constexpr size_t WS_Q = 92 * MiB;
constexpr size_t WS_K = 124 * MiB;
constexpr size_t WS_ZA = 156 * MiB;
constexpr size_t WS_GA = 188 * MiB;
constexpr size_t WS_GH = 252 * MiB;
constexpr size_t WS_UT = 316 * MiB;
constexpr size_t WS_END = 508 * MiB;
#ifndef PROBE_DUP
#define PROBE_DUP 0
#endif
#ifndef PROBE_MODE
#define PROBE_MODE 0
#endif

constexpr int LDS_BYTES = 160 * 1024;
constexpr int MISC_OFF = LDS_BYTES - 256;

__device__ __forceinline__ unsigned cvt_pk_bf16(float lo, float hi) { unsigned r; asm volatile("v_cvt_pk_bf16_f32 %0, %1, %2" : "=v"(r) : "v"(lo), "v"(hi)); return r; }
__device__ __forceinline__ float bf_lo(unsigned w) { return __uint_as_float(w << 16); }
__device__ __forceinline__ float bf_hi(unsigned w) { return __uint_as_float(w & 0xffff0000u); }
__device__ __forceinline__ float bf2f(bf16_t h) { return __uint_as_float(((unsigned)h) << 16); }
__device__ __forceinline__ float shx(float v, int o, int lane) { return __uint_as_float((unsigned)__builtin_amdgcn_ds_bpermute((lane ^ o) << 2, (int)__float_as_uint(v))); }
__device__ __forceinline__ float sum_halves(float v) { const auto rr = __builtin_amdgcn_permlane32_swap(__float_as_uint(v), __float_as_uint(v), false, false); return __uint_as_float(rr[0]) + __uint_as_float(rr[1]); }
__device__ __forceinline__ float wave_sum(float v, int lane) {
#pragma unroll
    for (int o = 1; o < 32; o <<= 1) v += shx(v, o, lane);
    return sum_halves(v);
}
typedef __amdgpu_buffer_rsrc_t rsrc_t;
__device__ __forceinline__ rsrc_t wt_rsrc(const void* base, unsigned nbytes) { return __builtin_amdgcn_make_buffer_rsrc((void*)base, 0, (int)nbytes, 0x00020000); }
__device__ __forceinline__ void wt_store16(rsrc_t r, unsigned off, u32x4 v) { __builtin_amdgcn_raw_buffer_store_b128(v, r, (int)off, 0, 16); }
__device__ __forceinline__ void wt_store4(rsrc_t r, unsigned off, float v) { __builtin_amdgcn_raw_buffer_store_b32(__float_as_uint(v), r, (int)off, 0, 16); }
__device__ __forceinline__ void attn_glds(const void* gsrc, unsigned ldsdst) { unsigned keep_;
    asm volatile("s_mov_b32 %0, m0\n\ts_mov_b32 m0, %2\n\ts_nop 0\n\tglobal_load_lds_dwordx4 %1, off\n\ts_mov_b32 m0, %0" : "=&s"(keep_) : "v"(gsrc), "s"(ldsdst) : "memory"); }
__device__ __forceinline__ float fast_sigmoid(float g) { return __builtin_amdgcn_rcpf(1.0f + __builtin_amdgcn_exp2f(-g * LOG2E)); }

namespace pg8 {
constexpr int BM = 256, BK = 64, HALF = 128, HTB = HALF * BK * 2, STAGE_BYTES = 8 * HTB, NXCD = 8, WGM = 4;
__host__ __device__ __forceinline__ int lds_byte(int r, int c) { const int st = (r >> 4) * 2 + (c >> 5), rr = r & 15, cc = c & 31, ob = rr * 64 + cc * 2; return st * 1024 + (ob ^ (((ob >> 9) & 1) << 5)); }
__host__ __device__ __forceinline__ void stage_rc(int b, int& R, int& C) { const int st = b / 1024, sb = b % 1024, swz = sb ^ (((sb >> 9) & 1) << 5); R = (st >> 1) * 16 + swz / 64; C = (st & 1) * 32 + (swz % 64) / 2; }
__host__ __device__ __forceinline__ int perm32(int rho) { const int n = rho >> 4, i = rho & 15; return 8 * (i >> 2) + 4 * n + (i & 3); }
struct Unit { int pm, pn; };
struct Gemm { const bf16_t* A; const bf16_t* Bt; int M, N, K; };
struct StaticOrder {
    int nM, nN, nwg, G, c, reps;
    __host__ __device__ void init(int M, int N, int G_, int c_, int reps_ = 1) { nM = M / BM; nN = N / BM; nwg = nM * nN; G = G_; c = c_; reps = reps_; }
    __host__ __device__ bool next(int i, Unit& u) const {
        if (reps > 1) { const int rounds = (nwg + G - 1) / G; if (i >= reps * rounds) return false; i %= rounds; }
        const long L = (long)i * G + c; if (L >= nwg) return false;
        int wgid = (int)L; { const int q = nwg / NXCD, r = nwg % NXCD, xcd = wgid % NXCD, off = wgid / NXCD; wgid = (xcd < r ? xcd * (q + 1) : r * (q + 1) + (xcd - r) * q) + off; }
        const int nig = WGM * nN, gid = wgid / nig, fm = gid * WGM, gsz = (nM - fm) < WGM ? (nM - fm) : WGM;
        u.pm = fm + ((wgid % nig) % gsz); u.pn = (wgid % nig) / gsz; return true;
    }
    __device__ __forceinline__ void a_ready(const Unit&) const {}
    __device__ __forceinline__ void done(const Unit&) const {}
};
struct PairOrder {
    int pm, pn0;
    __device__ __forceinline__ bool next(int i, Unit& u) const { if (i >= 2) return false; u.pm = pm; u.pn = pn0 + i; return true; }
    __device__ __forceinline__ void a_ready(const Unit&) const {}
    __device__ __forceinline__ void done(const Unit&) const {}
};

__device__ __forceinline__ unsigned trimg_off(unsigned row, unsigned ch) { return 256u * row + 16u * (ch ^ (((row & 3u) << 2) | ((row >> 2) & 3u))); }
template <int OFF> __device__ __forceinline__ u32x2 tr_rd(unsigned addr) { u32x2 r; asm volatile("ds_read_b64_tr_b16 %0, %1 offset:%2" : "=&v"(r) : "v"(addr), "i"(OFF) : "memory"); return r; }
template <class Epi, class Sched, bool ALIGN_EPI = true, bool SP2 = true, bool ATR = false>
__device__ __forceinline__ void gemm_phase(LAS unsigned char* lds, const Gemm g, const Sched& S, const Epi& E, const int tid) {
    const int wid = __builtin_amdgcn_readfirstlane(tid >> 6), lane = tid & 63, wr = wid >> 2, wc = wid & 3, fr = lane & 15, fq = lane >> 4;
    const int K = g.K, nt = K / BK;
    unsigned voffA[2], voffB[2];
#pragma unroll
    for (int i = 0; i < 2; ++i) { int R, C; stage_rc(tid * 16 + i * 8192, R, C); const int Rb = Epi::PERM ? ((R & ~31) + perm32(R & 31)) : R;
        voffA[i] = (unsigned)(R * K + C) * 2u; voffB[i] = (unsigned)(Rb * K + C) * 2u;
        if constexpr (ATR) { const unsigned P = (unsigned)tid * 16u + (unsigned)i * 8192u, kr = P >> 8, cp = (P & 255u) >> 4, ch = cp ^ (((kr & 3u) << 2) | ((kr >> 2) & 3u));
            voffA[i] = kr * (unsigned)(MTOK * 2) + ch * 16u; } }
    const size_t kstep = (size_t)(BK * 2);
    const size_t hstep = (size_t)HALF * K * 2;
    const size_t tstep = 2 * hstep;
    const size_t kstepA = ATR ? (size_t)BK * MTOK * 2 : kstep, hstepA = ATR ? (size_t)HALF * 2 : hstep, tstepA = ATR ? (size_t)BM * 2 : tstep;
    unsigned tra[2][4];
    if constexpr (ATR) { const unsigned g_ = (unsigned)lane >> 4, q_ = ((unsigned)lane & 15u) >> 2, p_ = (unsigned)lane & 3u;
#pragma unroll
        for (int t_ = 0; t_ < 2; ++t_)
#pragma unroll
            for (int m_ = 0; m_ < 4; ++m_) tra[t_][m_] = (unsigned)(size_t)lds + trimg_off(8u * g_ + 4u * (unsigned)t_ + q_, 2u * (4u * (unsigned)wr + (unsigned)m_) + (p_ >> 1)) + 8u * (p_ & 1u); }
    u32x2 trv[4][2][2];
    const unsigned ldsw = (unsigned)wid * 1024u;
    const int aoff = lds_byte(wr * 64 + fr, fq * 8), boff = lds_byte(wc * 32 + fr, fq * 8);
#define PG8_SA(b, h) (((b) * 2 + (h)) * HTB)
#define PG8_SB(b, h) ((4 + (b) * 2 + (h)) * HTB)
#define PG8_STAGE(bufoff, gbase, voff) do { _Pragma("unroll") for (int _i = 0; _i < 2; ++_i) \
        __builtin_amdgcn_global_load_lds((const unsigned*)((const char*)(gbase) + (voff)[_i]), (LAS unsigned*)(lds + (bufoff) + ldsw + _i * 8192), 16, 0, 0); } while (0)
#define PG8_TR1(m, kk, b, h) do { trv[m][kk][0] = tr_rd<PG8_SA(b, h) + 8192 * (kk)>(tra[0][m]); trv[m][kk][1] = tr_rd<PG8_SA(b, h) + 8192 * (kk)>(tra[1][m]); } while (0)
#define PG8_LDA(dst, b, h) do { if constexpr (ATR) { PG8_TR1(0, 0, b, h); PG8_TR1(0, 1, b, h); PG8_TR1(1, 0, b, h); PG8_TR1(1, 1, b, h); PG8_TR1(2, 0, b, h); PG8_TR1(2, 1, b, h); PG8_TR1(3, 0, b, h); PG8_TR1(3, 1, b, h); } \
        else { _Pragma("unroll") for (int m = 0; m < 4; ++m) _Pragma("unroll") for (int k = 0; k < 2; ++k) dst[m][k] = *(const LAS bf16x8*)(lds + PG8_SA(b, h) + aoff + m * 2048 + k * 1024); } } while (0)
#define PG8_LDA_FIN(dst) do { if constexpr (ATR) { asm volatile("s_waitcnt lgkmcnt(0)" : "+v"(trv[0][0][0]), "+v"(trv[0][0][1]), "+v"(trv[0][1][0]), "+v"(trv[0][1][1]), "+v"(trv[1][0][0]), "+v"(trv[1][0][1]), "+v"(trv[1][1][0]), "+v"(trv[1][1][1]), \
            "+v"(trv[2][0][0]), "+v"(trv[2][0][1]), "+v"(trv[2][1][0]), "+v"(trv[2][1][1]), "+v"(trv[3][0][0]), "+v"(trv[3][0][1]), "+v"(trv[3][1][0]), "+v"(trv[3][1][1]) :: "memory"); \
        _Pragma("unroll") for (int m = 0; m < 4; ++m) _Pragma("unroll") for (int k = 0; k < 2; ++k) { const u32x4 w_ = {trv[m][k][0].x, trv[m][k][0].y, trv[m][k][1].x, trv[m][k][1].y}; dst[m][k] = __builtin_bit_cast(bf16x8, w_); } } } while (0)
#define PG8_LDB(dst, b, h) do { _Pragma("unroll") for (int n = 0; n < 2; ++n) _Pragma("unroll") for (int k = 0; k < 2; ++k) dst[n][k] = *(const LAS bf16x8*)(lds + PG8_SB(b, h) + boff + n * 2048 + k * 1024); } while (0)
#define PG8_MMA(ai, bj, At, Bt) do { __builtin_amdgcn_s_setprio(1); _Pragma("unroll") for (int m = 0; m < 4; ++m) _Pragma("unroll") for (int n = 0; n < 2; ++n) _Pragma("unroll") for (int k = 0; k < 2; ++k) \
        acc[ai][bj][m][n] = __builtin_amdgcn_mfma_f32_16x16x32_bf16(Bt[n][k], At[m][k], acc[ai][bj][m][n], 0, 0, 0); __builtin_amdgcn_s_setprio(0); } while (0)
#define PG8_WAIT_V(n) asm volatile("s_waitcnt vmcnt(" #n ")" ::: "memory")
#define PG8_WAIT_L(n) asm volatile("s_waitcnt lgkmcnt(" #n ")" ::: "memory")
#define PG8_BAR __builtin_amdgcn_s_barrier()
#define PG8_SCHED __builtin_amdgcn_sched_barrier(0)
    Unit cur, nxt; int ui = 0;
    if (!S.next(0, cur)) return;
    f32x4 acc[2][2][4][2];
#pragma unroll
    for (int a = 0; a < 2; ++a)
#pragma unroll
        for (int b = 0; b < 2; ++b)
#pragma unroll
            for (int m = 0; m < 4; ++m)
#pragma unroll
                for (int n = 0; n < 2; ++n) acc[a][b][m][n] = (f32x4){0.f, 0.f, 0.f, 0.f};
    bf16x8 At[4][2], B0[2][2], B1[2][2];
    const char* cA = (const char*)g.A + (size_t)cur.pm * tstepA; const char* cB = (const char*)g.Bt + (size_t)cur.pn * tstep;
    S.a_ready(cur);
    if constexpr (SP2) {
        PG8_STAGE(PG8_SB(0, 0), cB, voffB); PG8_STAGE(PG8_SB(0, 1), cB + hstep, voffB); PG8_STAGE(PG8_SA(0, 0), cA, voffA); PG8_STAGE(PG8_SA(0, 1), cA + hstepA, voffA);
        if (wr == 1) PG8_BAR;
        PG8_WAIT_V(2); PG8_BAR;
        PG8_STAGE(PG8_SB(1, 0), cB + kstep, voffB); PG8_STAGE(PG8_SA(1, 0), cA + kstepA, voffA); PG8_STAGE(PG8_SB(1, 1), cB + hstep + kstep, voffB);
        PG8_WAIT_V(6); PG8_BAR;
    } else {
        PG8_STAGE(PG8_SB(0, 0), cB, voffB); PG8_STAGE(PG8_SA(0, 0), cA, voffA); PG8_STAGE(PG8_SB(0, 1), cB + hstep, voffB); PG8_STAGE(PG8_SA(0, 1), cA + hstep, voffA);
        if (wr == 1) PG8_BAR;
        PG8_WAIT_V(4); PG8_BAR;
        PG8_STAGE(PG8_SB(1, 0), cB + kstep, voffB); PG8_STAGE(PG8_SA(1, 0), cA + kstep, voffA); PG8_STAGE(PG8_SB(1, 1), cB + hstep + kstep, voffB);
        PG8_WAIT_V(6); PG8_BAR;
    }
    for (;;) {
        const bool has_next = S.next(ui + 1, nxt);
        typename Epi::Pre pre; E.prefetch(pre, cur, wr, wc, fr, fq);
        const char* nA = has_next ? (const char*)g.A + (size_t)nxt.pm * tstepA : cA; const char* nB = has_next ? (const char*)g.Bt + (size_t)nxt.pn * tstep : cB;
        for (int t = 0; t < nt; t += 2) {
            const bool last = (t == nt - 2);
            const char* a1 = cA + (size_t)(t + 1) * kstepA;
            const char* a2 = last ? nA : cA + (size_t)(t + 2) * kstepA; const char* b2 = last ? nB : cB + (size_t)(t + 2) * kstep;
            const char* a3 = a2 + kstepA; const char* b3 = b2 + kstep;
            if (last && has_next) S.a_ready(nxt);
            if constexpr (SP2) {
            PG8_LDB(B0, 0, 0); PG8_LDB(B1, 0, 1); PG8_SCHED; PG8_LDA(At, 0, 0); PG8_STAGE(PG8_SA(1, 1), a1 + hstepA, voffA);
            PG8_WAIT_V(8); PG8_WAIT_L(0); PG8_LDA_FIN(At); PG8_BAR; PG8_MMA(0, 0, At, B0); PG8_MMA(0, 1, At, B1); PG8_BAR; PG8_SCHED;
            PG8_LDA(At, 0, 1); PG8_STAGE(PG8_SB(0, 0), b2, voffB); PG8_STAGE(PG8_SB(0, 1), b2 + hstep, voffB); PG8_STAGE(PG8_SA(0, 0), a2, voffA);
            PG8_WAIT_V(8); PG8_WAIT_L(0); PG8_LDA_FIN(At); PG8_BAR; PG8_MMA(1, 0, At, B0); PG8_MMA(1, 1, At, B1); PG8_BAR; PG8_SCHED;
            PG8_LDB(B0, 1, 0); PG8_LDB(B1, 1, 1); PG8_SCHED; PG8_LDA(At, 1, 0); PG8_STAGE(PG8_SA(0, 1), a2 + hstepA, voffA);
            PG8_WAIT_V(8); PG8_WAIT_L(0); PG8_LDA_FIN(At); PG8_BAR; PG8_MMA(0, 0, At, B0); PG8_MMA(0, 1, At, B1); PG8_BAR; PG8_SCHED;
            PG8_LDA(At, 1, 1); PG8_STAGE(PG8_SB(1, 0), b3, voffB); PG8_STAGE(PG8_SB(1, 1), b3 + hstep, voffB); PG8_STAGE(PG8_SA(1, 0), a3, voffA);
            PG8_WAIT_V(8); PG8_WAIT_L(0); PG8_LDA_FIN(At); PG8_BAR; PG8_MMA(1, 0, At, B0); PG8_MMA(1, 1, At, B1); PG8_BAR; PG8_SCHED;
            } else {
            PG8_LDB(B0, 0, 0); PG8_SCHED; PG8_LDA(At, 0, 0); PG8_STAGE(PG8_SA(1, 1), a1 + hstep, voffA);
            PG8_WAIT_L(8); PG8_BAR; PG8_WAIT_L(0); PG8_MMA(0, 0, At, B0); PG8_BAR; PG8_SCHED;
            PG8_LDB(B1, 0, 1); PG8_STAGE(PG8_SB(0, 0), b2, voffB);
            PG8_BAR; PG8_WAIT_L(0); PG8_MMA(0, 1, At, B1); PG8_BAR;
            PG8_LDA(At, 0, 1); PG8_STAGE(PG8_SA(0, 0), a2, voffA);
            PG8_BAR; PG8_WAIT_L(0); PG8_MMA(1, 0, At, B0); PG8_BAR; PG8_SCHED;
            PG8_STAGE(PG8_SB(0, 1), b2 + hstep, voffB);
            PG8_WAIT_V(6); PG8_BAR; PG8_MMA(1, 1, At, B1); PG8_BAR;
            PG8_LDB(B0, 1, 0); PG8_SCHED; PG8_LDA(At, 1, 0); PG8_STAGE(PG8_SA(0, 1), a2 + hstep, voffA);
            PG8_WAIT_L(8); PG8_BAR; PG8_WAIT_L(0); PG8_MMA(0, 0, At, B0); PG8_BAR; PG8_SCHED;
            PG8_LDB(B1, 1, 1); PG8_STAGE(PG8_SB(1, 0), b3, voffB);
            PG8_BAR; PG8_WAIT_L(0); PG8_MMA(0, 1, At, B1); PG8_BAR;
            PG8_LDA(At, 1, 1); PG8_STAGE(PG8_SA(1, 0), a3, voffA);
            PG8_BAR; PG8_WAIT_L(0); PG8_MMA(1, 0, At, B0); PG8_BAR; PG8_SCHED;
            PG8_STAGE(PG8_SB(1, 1), b3 + hstep, voffB);
            PG8_WAIT_V(6); PG8_BAR; PG8_MMA(1, 1, At, B1); PG8_BAR;
            }
        }
        if constexpr (ALIGN_EPI) { if (wr == 0) PG8_BAR; }
        E(acc, cur, wr, wc, fr, fq, pre); S.done(cur);
        if (!has_next) break;
#pragma unroll
        for (int a = 0; a < 2; ++a)
#pragma unroll
            for (int b = 0; b < 2; ++b)
#pragma unroll
                for (int m = 0; m < 4; ++m)
#pragma unroll
                    for (int n = 0; n < 2; ++n) acc[a][b][m][n] = (f32x4){0.f, 0.f, 0.f, 0.f};
        cur = nxt; cA = nA; cB = nB; ++ui;
        if constexpr (ALIGN_EPI) { if (wr == 1) PG8_BAR; }
    }
    PG8_WAIT_V(0);
    if constexpr (!ALIGN_EPI) { if (wr == 0) PG8_BAR; }
    PG8_BAR;
#undef PG8_SA
#undef PG8_SB
#undef PG8_STAGE
#undef PG8_LDA
#undef PG8_LDA_FIN
#undef PG8_TR1
#undef PG8_LDB
#undef PG8_MMA
#undef PG8_WAIT_V
#undef PG8_WAIT_L
#undef PG8_BAR
#undef PG8_SCHED
}

struct EpiA1 {
    static constexpr bool PERM = true;
    const float* rs; bf16_t *Q, *K, *ZA, *GA, *GH;
    struct Pre { float rsv[2][4]; };
    __device__ __forceinline__ void prefetch(Pre& p, const Unit& u, int wr, int wc, int fr, int fq) const {
        const int row0 = u.pm * BM + wr * 64 + fr;
#pragma unroll
        for (int ai = 0; ai < 2; ++ai)
#pragma unroll
            for (int m = 0; m < 4; ++m) p.rsv[ai][m] = rs[row0 + ai * HALF + m * 16];
    }
    __device__ __forceinline__ void operator()(const f32x4 (&acc)[2][2][4][2], const Unit& u, int wr, int wc, int fr, int fq, const Pre& p) const {
        bf16_t* base; int ld, colt; float sc = 1.f; const int pn = u.pn;
        if (pn < 2) { base = Q; ld = 512; colt = pn * 256; sc = QSCALE; }
        else if (pn < 4) { base = K; ld = 512; colt = (pn - 2) * 256; }
        else if (pn < 6) { base = ZA; ld = 512; colt = (pn - 4) * 256; }
        else if (pn < 10) { base = GA; ld = 1024; colt = (pn - 6) * 256; }
        else { base = GH; ld = 1024; colt = (pn - 10) * 256; }
        const int row0 = u.pm * BM + wr * 64 + fr, col0 = colt + wc * 32 + 8 * fq;
#pragma unroll
        for (int ai = 0; ai < 2; ++ai)
#pragma unroll
            for (int m = 0; m < 4; ++m) { const int row = row0 + ai * HALF + m * 16; const float s = p.rsv[ai][m] * sc; bf16_t* rowp = base + (size_t)row * ld + col0;
#pragma unroll
                for (int bj = 0; bj < 2; ++bj) { const f32x4 v0 = acc[ai][bj][m][0] * s, v1 = acc[ai][bj][m][1] * s;
                    u32x4 w; w.x = cvt_pk_bf16(v0[0], v0[1]); w.y = cvt_pk_bf16(v0[2], v0[3]); w.z = cvt_pk_bf16(v1[0], v1[1]); w.w = cvt_pk_bf16(v1[2], v1[3]);
                    *(u32x4*)(rowp + bj * HALF) = w; } }
    }
};
struct EpiA2 {
    static constexpr bool PERM = true;
    const float* rs; bf16_t* UT;
    struct Pre { f32x4 sv[2][2]; };
    __device__ __forceinline__ void prefetch(Pre& p, const Unit& u, int wr, int wc, int fr, int fq) const {
        const int col0 = u.pn * BM + wc * 32 + 8 * fq;
#pragma unroll
        for (int bj = 0; bj < 2; ++bj)
#pragma unroll
            for (int n = 0; n < 2; ++n) p.sv[bj][n] = *(const f32x4*)(rs + col0 + bj * HALF + 4 * n);
    }
    __device__ __forceinline__ void operator()(const f32x4 (&acc)[2][2][4][2], const Unit& u, int wr, int wc, int fr, int fq, const Pre& p) const {
        const int row0 = u.pm * BM + wr * 64 + fr, col0 = u.pn * BM + wc * 32 + 8 * fq;
#pragma unroll
        for (int ai = 0; ai < 2; ++ai)
#pragma unroll
            for (int m = 0; m < 4; ++m) { bf16_t* rowp = UT + (size_t)(row0 + ai * HALF + m * 16) * MTOK + col0;
#pragma unroll
                for (int bj = 0; bj < 2; ++bj) { const f32x4 v0 = acc[ai][bj][m][0] * p.sv[bj][0], v1 = acc[ai][bj][m][1] * p.sv[bj][1];
                    u32x4 w; w.x = cvt_pk_bf16(v0[0], v0[1]); w.y = cvt_pk_bf16(v0[2], v0[3]); w.z = cvt_pk_bf16(v1[0], v1[1]); w.w = cvt_pk_bf16(v1[2], v1[3]);
                    *(u32x4*)(rowp + bj * HALF) = w; } }
    }
};
struct EpiC1a {
    static constexpr bool PERM = true;
    bf16_t* GA; bf16_t* OUT;
    struct Pre { u32x4 g[4][2]; };
    __device__ __forceinline__ void loadh(u32x4 (&g)[4][2], int row0, int col0, int ai) const {
#pragma unroll
        for (int m = 0; m < 4; ++m)
#pragma unroll
            for (int bj = 0; bj < 2; ++bj) g[m][bj] = *(const u32x4*)(GA + (size_t)(row0 + ai * HALF + m * 16) * DM + col0 + bj * HALF);
    }
    __device__ __forceinline__ void prefetch(Pre& p, const Unit& u, int wr, int wc, int fr, int fq) const { loadh(p.g, u.pm * BM + wr * 64 + fr, u.pn * BM + wc * 32 + 8 * fq, 0); }
    __device__ __forceinline__ void half(const f32x4 (&acc)[2][2][4][2], const u32x4 (&gld)[4][2], int row0, int col0, int ai) const {
#pragma unroll
        for (int m = 0; m < 4; ++m) { bf16_t* rowp = GA + (size_t)(row0 + ai * HALF + m * 16) * DM + col0;
#pragma unroll
            for (int bj = 0; bj < 2; ++bj) { const u32x4 gv = gld[m][bj]; const f32x4 a0 = acc[ai][bj][m][0], a1 = acc[ai][bj][m][1];
                u32x4 w;
                w.x = cvt_pk_bf16(a0[0] * fast_sigmoid(bf_lo(gv.x)), a0[1] * fast_sigmoid(bf_hi(gv.x)));
                w.y = cvt_pk_bf16(a0[2] * fast_sigmoid(bf_lo(gv.y)), a0[3] * fast_sigmoid(bf_hi(gv.y)));
                w.z = cvt_pk_bf16(a1[0] * fast_sigmoid(bf_lo(gv.z)), a1[1] * fast_sigmoid(bf_hi(gv.z)));
                w.w = cvt_pk_bf16(a1[2] * fast_sigmoid(bf_lo(gv.w)), a1[3] * fast_sigmoid(bf_hi(gv.w)));
                *(u32x4*)(OUT + (rowp - GA) + bj * HALF) = w; } }
    }
    __device__ __forceinline__ void operator()(const f32x4 (&acc)[2][2][4][2], const Unit& u, int wr, int wc, int fr, int fq, const Pre& p) const {
        asm volatile("" : "+v"(fr), "+v"(fq));
        const int row0 = u.pm * BM + wr * 64 + fr, col0 = u.pn * BM + wc * 32 + 8 * fq;
        u32x4 g1[4][2]; loadh(g1, row0, col0, 1);
        half(acc, p.g, row0, col0, 0);
        half(acc, g1, row0, col0, 1);
    }
};
struct EpiC1b {
    static constexpr bool PERM = true;
    const bf16_t* GA; const bf16_t* GH; bf16_t* OUT;
    struct Pre { u32x4 gld[2][2]; };
    __device__ __forceinline__ void loadq(u32x4 (&pld)[2][2], u32x4 (&gld)[2][2], int row0, int col0, int q) const { const int ai = q >> 1, mh = q & 1;
#pragma unroll
        for (int mm = 0; mm < 2; ++mm)
#pragma unroll
            for (int bj = 0; bj < 2; ++bj) { const size_t off = (size_t)(row0 + ai * HALF + (2 * mh + mm) * 16) * DM + col0 + bj * HALF; pld[mm][bj] = *(const u32x4*)(GA + off); gld[mm][bj] = *(const u32x4*)(GH + off); }
    }
    __device__ __forceinline__ void prefetch(Pre& p, const Unit& u, int wr, int wc, int fr, int fq) const { const int row0 = u.pm * BM + wr * 64 + fr, col0 = u.pn * BM + wc * 32 + 8 * fq;
#pragma unroll
        for (int mm = 0; mm < 2; ++mm)
#pragma unroll
            for (int bj = 0; bj < 2; ++bj) p.gld[mm][bj] = *(const u32x4*)(GH + (size_t)(row0 + mm * 16) * DM + col0 + bj * HALF); }
    __device__ __forceinline__ void quarter(const f32x4 (&acc)[2][2][4][2], const u32x4 (&pld)[2][2], const u32x4 (&gld)[2][2], int row0, int col0, int q) const { const int ai = q >> 1, mh = q & 1;
#pragma unroll
        for (int mm = 0; mm < 2; ++mm) { const int m = 2 * mh + mm; const size_t off = (size_t)(row0 + ai * HALF + m * 16) * DM + col0;
#pragma unroll
            for (int bj = 0; bj < 2; ++bj) { const u32x4 pv = pld[mm][bj]; const u32x4 gv = gld[mm][bj];
                const f32x4 a0 = acc[ai][bj][m][0], a1 = acc[ai][bj][m][1];
                u32x4 w;
                w.x = cvt_pk_bf16(bf_lo(pv.x) + a0[0] * fast_sigmoid(bf_lo(gv.x)), bf_hi(pv.x) + a0[1] * fast_sigmoid(bf_hi(gv.x)));
                w.y = cvt_pk_bf16(bf_lo(pv.y) + a0[2] * fast_sigmoid(bf_lo(gv.y)), bf_hi(pv.y) + a0[3] * fast_sigmoid(bf_hi(gv.y)));
                w.z = cvt_pk_bf16(bf_lo(pv.z) + a1[0] * fast_sigmoid(bf_lo(gv.z)), bf_hi(pv.z) + a1[1] * fast_sigmoid(bf_hi(gv.z)));
                w.w = cvt_pk_bf16(bf_lo(pv.w) + a1[2] * fast_sigmoid(bf_lo(gv.w)), bf_hi(pv.w) + a1[3] * fast_sigmoid(bf_hi(gv.w)));
                *(u32x4*)(OUT + off + bj * HALF) = w; } }
    }
    __device__ __forceinline__ void operator()(const f32x4 (&acc)[2][2][4][2], const Unit& u, int wr, int wc, int fr, int fq, const Pre& p) const {
        asm volatile("" : "+v"(fr), "+v"(fq));
        const int row0 = u.pm * BM + wr * 64 + fr, col0 = u.pn * BM + wc * 32 + 8 * fq;
        u32x4 pa[2][2], ga[2][2], pb[2][2], gb[2][2], p0[2][2];
#pragma unroll
        for (int mm = 0; mm < 2; ++mm)
#pragma unroll
            for (int bj = 0; bj < 2; ++bj) p0[mm][bj] = *(const u32x4*)(GA + (size_t)(row0 + mm * 16) * DM + col0 + bj * HALF);
        loadq(pa, ga, row0, col0, 1); quarter(acc, p0, p.gld, row0, col0, 0);
        loadq(pb, gb, row0, col0, 2); quarter(acc, pa, ga, row0, col0, 1);
        loadq(pa, ga, row0, col0, 3); quarter(acc, pb, gb, row0, col0, 2);
        quarter(acc, pa, ga, row0, col0, 3);
    }
};
struct EpiC2 {
    static constexpr bool PERM = true;
    bf16_t* O; float* PART;
    struct Pre {};
    __device__ __forceinline__ void prefetch(Pre&, const Unit&, int, int, int, int) const {}
    __device__ __forceinline__ void operator()(const f32x4 (&acc)[2][2][4][2], const Unit& u, int wr, int wc, int fr, int fq, const Pre&) const {
        const int row0 = u.pm * BM + wr * 64 + fr, col0 = u.pn * BM + wc * 32 + 8 * fq;
#pragma unroll
        for (int ai = 0; ai < 2; ++ai)
#pragma unroll
            for (int m = 0; m < 4; ++m) { const int row = row0 + ai * HALF + m * 16; bf16_t* rowp = O + (size_t)row * DM + col0; float ss = 0.f;
#pragma unroll
                for (int bj = 0; bj < 2; ++bj) { const f32x4 v0 = acc[ai][bj][m][0], v1 = acc[ai][bj][m][1];
                    ss += (v0[0] * v0[0] + v0[1] * v0[1]) + (v0[2] * v0[2] + v0[3] * v0[3]) + (v1[0] * v1[0] + v1[1] * v1[1]) + (v1[2] * v1[2] + v1[3] * v1[3]);
                    u32x4 w; w.x = cvt_pk_bf16(v0[0], v0[1]); w.y = cvt_pk_bf16(v0[2], v0[3]); w.z = cvt_pk_bf16(v1[0], v1[1]); w.w = cvt_pk_bf16(v1[2], v1[3]);
                    *(u32x4*)(rowp + bj * HALF) = w; }
                ss += shx(ss, 16, fq * 16 + fr); ss = sum_halves(ss);
                if (fq == 0) PART[((size_t)u.pn * MTOK + row) * 4 + wc] = ss; }
    }
};
}

#define XB_TMO      128
#define XB_XCNT(j)  (256  + 64 * (j))
#define XB_XSUB(j)  (1280 + 64 * (j))
#define XB_XGEN(j)  (2304 + 64 * (j))
#define XB_TOP      3328
#define XB_TOPGEN   3392
#define XCD_BAR_WORDS 3456
#define XB_SPIN_CAP (1u << 18)
__device__ __forceinline__ unsigned xb_ld(unsigned* p)              { return __hip_atomic_load(p, __ATOMIC_RELAXED, __HIP_MEMORY_SCOPE_AGENT); }
__device__ __forceinline__ unsigned xb_add(unsigned* p, unsigned v) { return __hip_atomic_fetch_add(p, v, __ATOMIC_RELAXED, __HIP_MEMORY_SCOPE_AGENT); }
__device__ __forceinline__ unsigned xb_xcc_id() { return (unsigned)__builtin_amdgcn_s_getreg((3 << 11) | 20) & 0xFu; }
#define XB_SPIN(cond, bar) do { unsigned _sp = 0; while (cond) { __builtin_amdgcn_s_sleep(1); \
    if ((++_sp & 255u) == 0u) { if (xb_ld(&(bar)[XB_TMO])) break; if (_sp > XB_SPIN_CAP) { atomicAdd(&(bar)[XB_TMO], 1u); break; } } } } while (0)
struct XcdBarrier { unsigned* bar; unsigned x; volatile LAS unsigned* st; };
__device__ __forceinline__ XcdBarrier xcd_barrier_post(unsigned* bar, volatile LAS unsigned* st) {
    XcdBarrier b; b.bar = bar; b.x = xb_xcc_id(); b.st = st;
    if (threadIdx.x == 0) (void)xb_add(&bar[XB_XCNT(b.x)], 1u);
    return b;
}
__device__ __forceinline__ void xcd_barrier_complete(unsigned* bar, unsigned x, unsigned& nloc, unsigned& nx) {
    const unsigned G = gridDim.x * gridDim.y * gridDim.z;
    unsigned sum, cnt, mine, sp = 0u;
    for (;;) {
        sum = 0u; cnt = 0u; mine = 0u;
#pragma unroll
        for (unsigned j = 0; j < 16; ++j) { const unsigned c = xb_ld(&bar[XB_XCNT(j)]); sum += c; cnt += (c > 0u) ? 1u : 0u; mine = (j == x) ? c : mine; }
        if (sum == G) break;
        __builtin_amdgcn_s_sleep(1);
        if ((++sp & 255u) == 0u) { if (xb_ld(&bar[XB_TMO])) break; if (sp > XB_SPIN_CAP) { atomicAdd(&bar[XB_TMO], 1u); break; } }
    }
    nloc = mine > 0u ? mine : 1u; nx = cnt > 0u ? cnt : 1u;
}
__device__ __forceinline__ void xcd_barrier(const XcdBarrier& b) {
    asm volatile("s_waitcnt vmcnt(0)" ::: "memory");
    __syncthreads();
    if (threadIdx.x == 0) {
        unsigned* bar = b.bar;
        __builtin_amdgcn_s_waitcnt(0);
        unsigned nloc = b.st[0], nx = b.st[1];
        if (nloc == 0u) { xcd_barrier_complete(bar, b.x, nloc, nx); b.st[0] = nloc; b.st[1] = nx; }
        const unsigned old = xb_add(&bar[XB_XSUB(b.x)], 1u);
        const unsigned gen = old / nloc;
        if (old + 1u == (gen + 1u) * nloc) {
            __builtin_amdgcn_fence(__ATOMIC_RELEASE, "agent");
            asm volatile("s_waitcnt vmcnt(0)" ::: "memory");
            const unsigned og = xb_add(&bar[XB_TOP], 1u);
            const unsigned tg = og / nx;
            __builtin_amdgcn_fence(__ATOMIC_ACQUIRE, "agent");
            if (og + 1u == (tg + 1u) * nx) xb_add(&bar[XB_TOPGEN], 1u);
            else XB_SPIN(xb_ld(&bar[XB_TOPGEN]) == tg, bar);
            xb_add(&bar[XB_XGEN(b.x)], 1u);
            asm volatile("s_waitcnt vmcnt(0)" ::: "memory");
        } else {
            __builtin_amdgcn_fence(__ATOMIC_ACQUIRE, "agent");
            XB_SPIN(xb_ld(&bar[XB_XGEN(b.x)]) == gen, bar);
            asm volatile("s_waitcnt vmcnt(0)" ::: "memory");
        }
    }
    __syncthreads();
}

__device__ __forceinline__ void pair_post(unsigned* cnt, bool samex, int tid) {
    asm volatile("s_waitcnt vmcnt(0)" ::: "memory");
    __syncthreads();
    if (tid < 64) {
        if (!samex) { __builtin_amdgcn_fence(__ATOMIC_RELEASE, "agent"); asm volatile("s_waitcnt vmcnt(0)" ::: "memory"); }
        if (tid == 0) (void)xb_add(cnt, 1u);
    }
}
__device__ __forceinline__ void pair_wait(unsigned* ctl, unsigned* cnt, unsigned need, int tid) {
    if (tid < 64) {
        unsigned sp = 0;
        __builtin_amdgcn_fence(__ATOMIC_ACQUIRE, "agent");
        while ((unsigned)__builtin_amdgcn_readfirstlane(xb_ld(cnt)) < need) { __builtin_amdgcn_s_sleep(1);
            if ((++sp & 255u) == 0u) { if (__builtin_amdgcn_readfirstlane(xb_ld(&ctl[XB_TMO]))) break; if (sp > XB_SPIN_CAP) { if (tid == 0) atomicAdd(&ctl[XB_TMO], 1u); break; } } }
        asm volatile("s_waitcnt vmcnt(0)" ::: "memory");
    }
    __syncthreads();
}

enum { I_X = 0, I_RELB, I_PRE, I_POST, I_WIN, I_LQ1, I_LK1, I_LQ2, I_LK2, I_SUBLN, I_CW, I_CB, I_FW1, I_FB1, I_FW2, I_FB2, I_FW3, I_FB3, I_FFREQ, I_FWOUT, I_FDELTA, I_FBIAS, I_WPA, I_WPH, I_WOUT, N_IN };
struct Args { const float* in[N_IN]; float* out; unsigned char* ws; int ph_lo, ph_hi; };

typedef const __attribute__((address_space(4))) unsigned char* kargp_t;
__device__ __forceinline__ kargp_t kargs_base() { kargp_t p = (kargp_t)__builtin_amdgcn_kernarg_segment_ptr(); asm volatile("" : "+s"(p)); return p; }
__device__ __forceinline__ const float* kin(int i) { return *(const float* const __attribute__((address_space(4)))*)(kargs_base() + 8 * i); }
__device__ __forceinline__ float* kout() { return *(float* const __attribute__((address_space(4)))*)(kargs_base() + 8 * N_IN); }
__device__ __forceinline__ unsigned char* kws() { return *(unsigned char* const __attribute__((address_space(4)))*)(kargs_base() + 8 * N_IN + 8); }


__device__ __forceinline__ void norm_rows(const Args& a, int lnext, int rbeg, int rend, int rstep, int lane, const bool dummy = false) {
    unsigned char* ws = kws();
    const float* xin = kin(I_X); float* out = kout();
    const bf16_t* O = (const bf16_t*)(ws + WS_GH); const float* PART = (const float*)(ws + WS_PART);
    const bf16_t* XB = (const bf16_t*)(ws + WS_XB); bf16_t* XBo = dummy ? (bf16_t*)out : (bf16_t*)(ws + WS_XB); float* RS = dummy ? out + (size_t)16 * MiB : (float*)(ws + WS_RS);
    f32x4 gpost[4];
    if (lnext > 0) {
#pragma unroll
        for (int j = 0; j < 4; ++j) gpost[j] = *(const f32x4*)(kin(I_POST) + (size_t)(lnext - 1) * DM + 4 * lane + 256 * j);
    }
    constexpr int NB = 8;
    for (int row0 = rbeg; row0 < rend; row0 += NB * rstep) {
        f32x4 xf[NB][4]; u32x2 xw[NB][4], ow[NB][4]; float pp[NB];
#pragma unroll
        for (int i = 0; i < NB; ++i) { const int row = (row0 + i * rstep < rend) ? row0 + i * rstep : row0;
            if (lnext == 0) {
#pragma unroll
                for (int j = 0; j < 4; ++j) xf[i][j] = *(const f32x4*)(xin + (size_t)row * DM + 4 * lane + 256 * j);
            } else {
#pragma unroll
                for (int j = 0; j < 4; ++j) { xw[i][j] = *(const u32x2*)(XB + (size_t)row * DM + 4 * lane + 256 * j); ow[i][j] = *(const u32x2*)(O + (size_t)row * DM + 4 * lane + 256 * j); }
                pp[i] = PART[((size_t)((lane & 15) >> 2) * MTOK + row) * 4 + (lane & 3)]; } }
#pragma unroll
        for (int i = 0; i < NB; ++i) { const int row = row0 + i * rstep; if (row >= rend) break;
            f32x4 v[4];
            if (lnext == 0) {
#pragma unroll
                for (int j = 0; j < 4; ++j) v[j] = xf[i][j];
            } else {
                const float rso = __builtin_amdgcn_rsqf(wave_sum(lane < 16 ? pp[i] : 0.f, lane) * (1.0f / DM) + 1e-6f);
#pragma unroll
                for (int j = 0; j < 4; ++j) {
                    v[j][0] = bf_lo(xw[i][j].x) + bf_lo(ow[i][j].x) * rso * gpost[j][0]; v[j][1] = bf_hi(xw[i][j].x) + bf_hi(ow[i][j].x) * rso * gpost[j][1];
                    v[j][2] = bf_lo(xw[i][j].y) + bf_lo(ow[i][j].y) * rso * gpost[j][2]; v[j][3] = bf_hi(xw[i][j].y) + bf_hi(ow[i][j].y) * rso * gpost[j][3]; }
            }
            if (lnext < DEPTH) {
                float sq = 0.f;
#pragma unroll
                for (int j = 0; j < 4; ++j) sq += (v[j][0] * v[j][0] + v[j][1] * v[j][1]) + (v[j][2] * v[j][2] + v[j][3] * v[j][3]);
                sq = wave_sum(sq, lane);
                if (lane == 0) RS[row] = __builtin_amdgcn_rsqf(sq * (1.0f / DM) + 1e-6f);
#pragma unroll
                for (int j = 0; j < 4; ++j) { u32x2 w; w.x = cvt_pk_bf16(v[j][0], v[j][1]); w.y = cvt_pk_bf16(v[j][2], v[j][3]); *(u32x2*)(XBo + (size_t)row * DM + 4 * lane + 256 * j) = w; }
            } else {
#pragma unroll
                for (int j = 0; j < 4; ++j) *(f32x4*)(out + (size_t)row * DM + 4 * lane + 256 * j) = v[j];
            }
        }
    }
}
__device__ __forceinline__ void transpose_item(const float* W, int ldw, int k0, int nsrc0, const float* gain, bf16_t* WT, int ldt, int ndst0, LAS float* scr, int lane) {
#pragma unroll 1
    for (int kb = 0; kb < 64; kb += 32) { float v[32], gv[32];
#pragma unroll
        for (int i = 0; i < 32; ++i) v[i] = W[(size_t)(k0 + kb + i) * ldw + nsrc0 + lane];
        if (gain) {
#pragma unroll
            for (int i = 0; i < 32; ++i) gv[i] = gain[k0 + kb + i];
#pragma unroll
            for (int i = 0; i < 32; ++i) v[i] *= gv[i]; }
#pragma unroll
        for (int i = 0; i < 32; ++i) scr[(kb + i) * 65 + lane] = v[i]; }
    asm volatile("s_waitcnt lgkmcnt(0)" ::: "memory");
#pragma unroll
    for (int it = 0; it < 8; ++it) { const int q = it * 64 + lane, n = q >> 3, kc = q & 7; const LAS float* s = scr + (8 * kc) * 65 + n;
        u32x4 o; o.x = cvt_pk_bf16(s[0 * 65], s[1 * 65]); o.y = cvt_pk_bf16(s[2 * 65], s[3 * 65]); o.z = cvt_pk_bf16(s[4 * 65], s[5 * 65]); o.w = cvt_pk_bf16(s[6 * 65], s[7 * 65]);
        *(u32x4*)(WT + (size_t)(ndst0 + n) * ldt + k0 + 8 * kc) = o; }
    asm volatile("s_waitcnt lgkmcnt(0)" ::: "memory");
}
__device__ __forceinline__ void convert_weights(const Args& a, int l, LAS unsigned char* lds, int gw, int NGW, int wave, int lane) {
    unsigned char* ws = kws();
    LAS float* scr = (LAS float*)(lds + wave * 16640);
    const float* win = kin(I_WIN) + (size_t)l * DM * WIN; const float* gain = kin(I_PRE) + (size_t)l * DM;
    const float* wpa = kin(I_WPA) + (size_t)l * 512 * DM; const float* wph = kin(I_WPH) + (size_t)l * 512 * DM; const float* wout = kin(I_WOUT) + (size_t)l * DM * DM;
    bf16_t* WA1 = (bf16_t*)(ws + WS_WA1); bf16_t* WA2 = (bf16_t*)(ws + WS_WA2); const size_t cset = (size_t)(l & 1) * WS_WC2; bf16_t* WPA = (bf16_t*)(ws + WS_WPA + cset); bf16_t* WPH = (bf16_t*)(ws + WS_WPH + cset); bf16_t* WOUT = (bf16_t*)(ws + WS_WOUT + cset);
    constexpr int I_IN = 16 * 96, I_PA = 8 * 16, I_PH = 8 * 16, I_OUT = 16 * 16, NITEMS = I_IN + I_PA + I_PH + I_OUT;
    for (int it = gw; it < NITEMS; it += NGW) {
        int r = it;
        if (r < I_IN) { const int kb = r / 96, nb = r % 96; const int d0 = nb * 64;
            int src; bf16_t* dst; int drow;
            if (d0 < NA1) { dst = WA1; drow = d0; src = d0 < 1024 ? d0 : (d0 < 1536 ? 1536 + (d0 - 1024) : 4096 + (d0 - 1536)); }
            else { const int e = d0 - NA1; dst = WA2; drow = e; src = e < 512 ? 1024 + e : 2048 + (e - 512); }
            transpose_item(win, WIN, kb * 64, src, gain, dst, DM, drow, scr, lane); continue; }
        r -= I_IN;
        if (r < I_PA) { transpose_item(wpa, DM, (r / 16) * 64, (r % 16) * 64, nullptr, WPA, 512, (r % 16) * 64, scr, lane); continue; }
        r -= I_PA;
        if (r < I_PH) { transpose_item(wph, DM, (r / 16) * 64, (r % 16) * 64, nullptr, WPH, 512, (r % 16) * 64, scr, lane); continue; }
        r -= I_PH;
        transpose_item(wout, DM, (r / 16) * 64, (r % 16) * 64, nullptr, WOUT, DM, (r % 16) * 64, scr, lane);
    }
}
template <int K, int PITCH>
__device__ __forceinline__ void filt_layer(const LAS float* in, const float* W, const float* Bv, const float* fq, LAS float* out, int tid) {
    const int j = tid & 63, pg = tid >> 6;
    const float b0 = Bv[j]; float s0 = b0, s1 = b0, s2 = b0, s3 = b0, s4 = b0;
    const LAS float* r0 = in + pg * PITCH; const LAS float* r4 = in + 32 * PITCH;
    float wk[K];
#pragma unroll
    for (int k = 0; k < K; ++k) wk[k] = W[k * 64 + j];
#pragma unroll
    for (int k = 0; k < K; ++k) { const float w = wk[k];
        s0 += r0[k] * w; s1 += r0[8 * PITCH + k] * w; s2 += r0[16 * PITCH + k] * w; s3 += r0[24 * PITCH + k] * w; s4 += r4[k] * w; }
    const float f = fq[j];
    out[pg * 64 + j] = __builtin_amdgcn_sinf(f * s0 * 0.15915494309189535f); out[(pg + 8) * 64 + j] = __builtin_amdgcn_sinf(f * s1 * 0.15915494309189535f);
    out[(pg + 16) * 64 + j] = __builtin_amdgcn_sinf(f * s2 * 0.15915494309189535f); out[(pg + 24) * 64 + j] = __builtin_amdgcn_sinf(f * s3 * 0.15915494309189535f);
    if (pg == 0) out[32 * 64 + j] = __builtin_amdgcn_sinf(f * s4 * 0.15915494309189535f);
}
__device__ __forceinline__ void split_bf16x8(const float (&x)[8], bf16x8& hi, bf16x8& lo) {
    u32x4 h, l;
#pragma unroll
    for (int e = 0; e < 4; ++e) { const unsigned hw = cvt_pk_bf16(x[2 * e], x[2 * e + 1]); const unsigned lw = cvt_pk_bf16(x[2 * e] - bf_lo(hw), x[2 * e + 1] - bf_hi(hw)); h[e] = hw; l[e] = lw; }
    hi = __builtin_bit_cast(bf16x8, h); lo = __builtin_bit_cast(bf16x8, l);
}
__device__ __forceinline__ void make_filters(const Args& a, int l, LAS unsigned char* lds, int pb, int tid) {
    constexpr int NP = 33;
    LAS float* zs = (LAS float*)lds;
    LAS float* a1 = zs + NP * 36;
    LAS float* a2 = a1 + NP * 64;
    const float* w1 = kin(I_FW1) + (size_t)l * 33 * 64; const float* b1 = kin(I_FB1) + l * 64;
    const float* w2 = kin(I_FW2) + (size_t)l * 64 * 64; const float* b2 = kin(I_FB2) + l * 64;
    const float* w3 = kin(I_FW3) + (size_t)l * 64 * 64; const float* b3 = kin(I_FB3) + l * 64;
    const float* fq = kin(I_FFREQ) + l * 64; const float* wo = kin(I_FWOUT) + (size_t)l * 64 * 2048;
    const float* dl = kin(I_FDELTA) + l * 2048; const float* fb = kin(I_FBIAS) + l * 1024;
    bf16_t* FT = (bf16_t*)(kws() + WS_FT) + (size_t)l * (2 * 512 * 4096);
    const int i0 = pb * 32;
    __syncthreads();
    for (int idx = tid; idx < NP * 33; idx += NTHR) { const int p = idx / 33, k = idx % 33; const int i = i0 + p; float z;
        if (k == 0) z = (float)i * (1.0f / 2047.0f);
        else { const int j = (k - 1) & 15; const float f = 1e-4f + (float)j * ((15.0f - 1e-4f) / 15.0f); float ang = 6.283185307179586f * (float)i; ang = ang * f; ang = ang / 2048.0f;
            const float rev = ang * 0.15915494309189535f;
            z = (k <= 16) ? __builtin_amdgcn_cosf(rev) : -__builtin_amdgcn_sinf(rev); }
        zs[p * 36 + k] = z; }
    __syncthreads();
    filt_layer<33, 36>(zs, w1, b1, fq, a1, tid);
    __syncthreads();
    filt_layer<64, 64>(a1, w2, b2, fq, a2, tid);
    __syncthreads();
    filt_layer<64, 64>(a2, w3, b3, fq, a1, tid);
    __syncthreads();
    const int wave = tid >> 6, lane = tid & 63, li = lane & 15, lg = lane >> 4, dir = wave >> 2;
    bf16x8 Ah[2][2], Al[2][2];
#pragma unroll
    for (int mt = 0; mt < 2; ++mt)
#pragma unroll
        for (int ks = 0; ks < 2; ++ks) { const LAS float* src = a1 + (dir + 16 * mt + li) * 64 + 32 * ks + 8 * lg;
            const f32x4 x0 = *(const LAS f32x4*)src, x1 = *(const LAS f32x4*)(src + 4); const float x[8] = {x0[0], x0[1], x0[2], x0[3], x1[0], x1[1], x1[2], x1[3]};
            split_bf16x8(x, Ah[mt][ks], Al[mt][ks]); }
    float wn[2][8];
#pragma unroll
    for (int ks = 0; ks < 2; ++ks)
#pragma unroll
        for (int e = 0; e < 8; ++e) wn[ks][e] = wo[(size_t)(32 * ks + 8 * lg + e) * 2048 + 256 * wave + li];
#pragma unroll 2
    for (int nt = 0; nt < 16; ++nt) {
        const int fc = 256 * wave + 16 * nt + li;
        bf16x8 Bh[2], Bl[2];
#pragma unroll
        for (int ks = 0; ks < 2; ++ks) split_bf16x8(wn[ks], Bh[ks], Bl[ks]);
        { const int fn = 256 * wave + 16 * (nt < 15 ? nt + 1 : 15) + li;
#pragma unroll
          for (int ks = 0; ks < 2; ++ks)
#pragma unroll
              for (int e = 0; e < 8; ++e) wn[ks][e] = wo[(size_t)(32 * ks + 8 * lg + e) * 2048 + fn]; }
        f32x4 acc[2];
#pragma unroll
        for (int mt = 0; mt < 2; ++mt) { acc[mt] = (f32x4){0.f, 0.f, 0.f, 0.f};
#pragma unroll
            for (int ks = 0; ks < 2; ++ks) {
                acc[mt] = __builtin_amdgcn_mfma_f32_16x16x32_bf16(Al[mt][ks], Bh[ks], acc[mt], 0, 0, 0);
                acc[mt] = __builtin_amdgcn_mfma_f32_16x16x32_bf16(Ah[mt][ks], Bl[ks], acc[mt], 0, 0, 0);
                acc[mt] = __builtin_amdgcn_mfma_f32_16x16x32_bf16(Ah[mt][ks], Bh[ks], acc[mt], 0, 0, 0); } }
        const int o = (fc >> 9) & 1, c = fc & 511;
        const float dlt = fabsf(dl[fc]) * LOG2E, bvv = fb[o * 512 + c];
        bf16_t* row = FT + (size_t)(o * 512 + c) * 4096;
#pragma unroll
        for (int mt = 0; mt < 2; ++mt) { float v[4];
#pragma unroll
            for (int jj = 0; jj < 4; ++jj) { const int i = i0 + dir + 16 * mt + 4 * lg + jj; const float t = (float)i * (1.0f / 2047.0f);
                float x = acc[mt][jj] * __builtin_amdgcn_exp2f(-t * dlt); if (dir == 0 && i == 0) x += bvv; if (i > 2047) x = 0.f; v[jj] = x; }
            u32x2 w;
            if (dir == 0) { w.x = cvt_pk_bf16(v[0], v[1]); w.y = cvt_pk_bf16(v[2], v[3]); *(u32x2*)(row + 2048 + i0 + 16 * mt + 4 * lg) = w; }
            else { w.x = cvt_pk_bf16(v[3], v[2]); w.y = cvt_pk_bf16(v[1], v[0]); *(u32x2*)(row + 2044 - i0 - 16 * mt - 4 * lg) = w; } }
    }
}

constexpr int AT_KS = 0;
constexpr int AT_VS = 2 * 8192;
constexpr int AT_BT = AT_VS + 2 * 16384;
constexpr int AT_SL = AT_BT + 2048;
constexpr int AT_ST = AT_SL + 512;
constexpr int AT_QS = AT_ST + 8 * 2048 * 4;
static_assert(AT_QS + 8 * 4096 <= MISC_OFF, "attention LDS");
__device__ __forceinline__ int t5_bucket(int rel) {
    const int n = rel < 0 ? -rel : rel; const int base = rel > 0 ? 16 : 0; int v;
    if (n < 8) v = n; else if (n < 12) v = 8; else if (n < 16) v = 9; else if (n < 23) v = 10; else if (n < 32) v = 11; else if (n < 46) v = 12; else if (n < 64) v = 13; else if (n < 91) v = 14; else v = 15;
    return base + v;
}
__device__ __forceinline__ int swap23(int i) { return (i & ~12) | ((i & 4) << 1) | ((i & 8) >> 1); }

struct APre { u32x4 q[4]; };
__device__ __forceinline__ void attn_prefetch(APre& p, LAS unsigned char* lds, const bf16_t* Qb, const bf16_t* Kb, int b, int h, int c, int qb, int wave, int tid) {
    int tl = tid; asm volatile("" : "+v"(tl)); const int ln = tl & 63, ql = ln & 31, hi = ln >> 5;
    const int sR = 8 * wave + (ln >> 3), scl = (ln & 7) ^ ((sR >> 1) & 7);
    const bf16_t* kg = Kb + (size_t)(b * SEQ + ((sR & 32) | swap23(sR & 31))) * 512 + h * 128 + c * 64 + 8 * scl;
    const unsigned kd = (unsigned)(size_t)lds + AT_KS + 1024 * wave; unsigned keep_;
    asm volatile("s_mov_b32 %0, m0\n\ts_mov_b32 m0, %2\n\ts_nop 0\n\tglobal_load_lds_dwordx4 %1, off\n\ts_mov_b32 m0, %0" : "=&s"(keep_) : "v"(kg), "s"(kd) : "memory");
    asm volatile("s_mov_b32 %0, m0\n\ts_mov_b32 m0, %2\n\ts_nop 0\n\tglobal_load_lds_dwordx4 %1, off\n\ts_mov_b32 m0, %0" : "=&s"(keep_) : "v"(kg + (size_t)64 * 512), "s"(kd + 8192u) : "memory");
    const bf16_t* qp = Qb + (size_t)(b * SEQ + qb * 256 + wave * 32 + ql) * 512 + h * 128 + c * 64 + 8 * hi;
#pragma unroll
    for (int ks = 0; ks < 4; ++ks) attn_glds(qp + 16 * ks, (unsigned)(size_t)lds + AT_QS + wave * 4096 + ks * 1024);
    (void)p;
}
template <bool NORM, class PreTail>
__device__ __forceinline__ float attn_pass(LAS unsigned char* lds, const bf16_t* Qb, const bf16_t* Kb, const bf16_t* VT, int b, int h, int c, int qb, int wave, int lane, int tid, f32x16 (&O)[4], const int pmode, const APre& pin, const bool use_pin, PreTail&& pretail) {
    const int tmul = (pmode & 1) ? 0 : 1;
    { int tl = tid; asm volatile("" : "+v"(tl)); tid = tl; lane = tl & 63; }
    const int ql = lane & 31, hi = lane >> 5;
    const int qpos = qb * 256 + wave * 32 + ql;
    LAS unsigned char* qslot = lds + AT_QS + wave * 4096 + lane * 16;
#define AT_DMA_K(tile, bufi) __builtin_amdgcn_global_load_lds((const unsigned*)(kg + (size_t)(tile) * 64 * 512), (LAS unsigned*)(kdst + (bufi) * 8192), 16, 0, 0)
#define AT_DMA_V(tile, bufi) do { __builtin_amdgcn_global_load_lds((const unsigned*)(vg0 + (tile) * 64), (LAS unsigned*)(vdst + (bufi) * 16384), 16, 0, 0); \
                                  __builtin_amdgcn_global_load_lds((const unsigned*)(vg1 + (tile) * 64), (LAS unsigned*)(vdst + (bufi) * 16384 + 8192), 16, 0, 0); } while (0)
    const LAS float* btab = (const LAS float*)(lds + AT_BT);
    const float bc_pos = btab[256 + 128], bc_neg = btab[256 - 128];
    int ko[4];
#pragma unroll
    for (int ks = 0; ks < 4; ++ks) ko[ks] = ql * 128 + (((2 * ks + hi) ^ ((ql >> 1) & 7)) << 4);
    const int qrow0 = qb * 256 + wave * 32;
#define AT_SB() __builtin_amdgcn_sched_barrier(0)
    float m_ref = 0.f, l_run = 0.f;
    for (int attempt = 0; attempt < 6; ++attempt) {
    int il = tid; asm volatile("" : "+v"(il)); il &= 63;
    const int sR = 8 * wave + (il >> 3), scl = (il & 7) ^ ((sR >> 1) & 7);
    const bf16_t* kg = Kb + (size_t)(b * SEQ + ((sR & 32) | swap23(sR & 31))) * 512 + h * 128 + c * 64 + 8 * scl;
    const bf16_t* vg0 = VT + (size_t)(h * 128 + sR) * MTOK + b * SEQ + 8 * scl;
    const bf16_t* vg1 = vg0 + (size_t)64 * MTOK;
    LAS unsigned char* kdst = lds + AT_KS + 1024 * wave;
    LAS unsigned char* vdst = lds + AT_VS + 1024 * wave;
#pragma unroll
    for (int dt = 0; dt < 4; ++dt)
#pragma unroll
        for (int r = 0; r < 16; ++r) O[dt][r] = 0.f;
    l_run = 0.f;
    __syncthreads();
    if (use_pin && attempt == 0) {
        asm volatile("s_waitcnt vmcnt(0)" ::: "memory");
    } else {
        AT_DMA_K(0, 0); AT_DMA_K(1, 1);
        const bf16_t* qp = Qb + (size_t)(b * SEQ + qpos) * 512 + h * 128 + c * 64 + 8 * hi;
#pragma unroll
        for (int ks = 0; ks < 4; ++ks) *(LAS bf16x8*)(qslot + ks * 1024) = *(const bf16x8*)(qp + 16 * ks); }
    __syncthreads();
    f32x16 Sa0, Sa1, Sb0, Sb1;
    bf16x8 Qf[4];
    { bf16x8 kf[8];
      const LAS unsigned char* Ks = lds + AT_KS;
#pragma unroll
      for (int ks = 0; ks < 4; ++ks) { Qf[ks] = *(const LAS bf16x8*)(qslot + ks * 1024); kf[2 * ks] = *(const LAS bf16x8*)(Ks + ko[ks]); kf[2 * ks + 1] = *(const LAS bf16x8*)(Ks + 4096 + ko[ks]); }
      const int rel_lo = -(qrow0 + 31), rel_hi = 63 - qrow0;
      const float bc = (rel_lo >= 91 ? bc_pos : (rel_hi <= -91 ? bc_neg : 0.f));
#pragma unroll
      for (int r = 0; r < 16; ++r) { Sa0[r] = bc; Sa1[r] = bc; }
#pragma unroll
      for (int ks = 0; ks < 4; ++ks) {
          Sa0 = __builtin_amdgcn_mfma_f32_32x32x16_bf16(kf[2 * ks], Qf[ks], Sa0, 0, 0, 0);
          Sa1 = __builtin_amdgcn_mfma_f32_32x32x16_bf16(kf[2 * ks + 1], Qf[ks], Sa1, 0, 0, 0); }
      AT_SB();
      if (!(rel_lo >= 91 || rel_hi <= -91)) {
          const LAS float* bp = btab + (8 * hi - qpos + 256);
#pragma unroll
          for (int r = 0; r < 16; ++r) { Sa0[r] += bp[(r & 7) + 16 * (r >> 3)]; Sa1[r] += bp[32 + (r & 7) + 16 * (r >> 3)]; } }
      if (attempt == 0) {
          float mt = fmaxf(Sa0[0], Sa1[0]);
#pragma unroll
          for (int r = 1; r < 16; ++r) mt = fmaxf(mt, fmaxf(Sa0[r], Sa1[r]));
          { const auto rr = __builtin_amdgcn_permlane32_swap(__float_as_uint(mt), __float_as_uint(mt), false, false); mt = fmaxf(__uint_as_float(rr[0]), __uint_as_float(rr[1])); }
          m_ref = mt; }
#pragma unroll
      for (int r = 0; r < 16; ++r) { Sa0[r] -= m_ref; Sa1[r] -= m_ref; } }
    __syncthreads();
    bf16x8 Pf[4];
#pragma unroll
    for (int i = 0; i < 4; ++i) Pf[i] = (bf16x8){0, 0, 0, 0, 0, 0, 0, 0};
#define AT_SGB4() do { _Pragma("unroll") for (int i_ = 0; i_ < 4; ++i_) { __builtin_amdgcn_sched_group_barrier(0x008, 1, 0); __builtin_amdgcn_sched_group_barrier(0x100, 1, 0); __builtin_amdgcn_sched_group_barrier(0x402, 4, 0); } } while (0)
#define AT_ITERX(t, C0, C1, N0, N1, PV, QK) do { \
        if (QK) { const int tk = ((t) + 2 < 32 ? (t) + 2 : 31) * tmul; AT_DMA_K(tk, (t) & 1); }     \
        AT_DMA_V((t) * tmul, (t) & 1);     \
        { const int rel_lo = (t) * 64 - (qrow0 + 31), rel_hi = (t) * 64 + 63 - qrow0; \
          if ((t) > 0 && !(rel_lo >= 91 || rel_hi <= -91)) {   \
              const LAS float* bp = btab + ((t) * 64 + 8 * hi - qpos + 256); \
              _Pragma("unroll") for (int r = 0; r < 16; ++r) { C0[r] += bp[(r & 7) + 16 * (r >> 3)]; C1[r] += bp[32 + (r & 7) + 16 * (r >> 3)]; } } } \
        {   \
            \
            \
            const LAS unsigned char* Vs = lds + AT_VS + (((t) + 1) & 1) * 16384; \
            const LAS unsigned char* Ks = lds + AT_KS + (((t) + 1) & 1) * 8192; \
            bf16x8 vA[4], vB[4], kf[8]; float ps = 0.f; u32x4 w; \
            if (PV) { _Pragma("unroll") for (int dt = 0; dt < 4; ++dt) vA[dt] = *(const LAS bf16x8*)(Vs + dt * 4096 + ko[0]); } \
            if (PV) { _Pragma("unroll") for (int dt = 0; dt < 4; ++dt) vB[dt] = *(const LAS bf16x8*)(Vs + dt * 4096 + ko[1]); } \
            AT_SB(); \
            if (PV) { _Pragma("unroll") for (int dt = 0; dt < 4; ++dt) O[dt] = __builtin_amdgcn_mfma_f32_32x32x16_bf16(vA[dt], Pf[0], O[dt], 0, 0, 0); } \
            if (PV) { _Pragma("unroll") for (int dt = 0; dt < 4; ++dt) vA[dt] = *(const LAS bf16x8*)(Vs + dt * 4096 + ko[2]); } \
            _Pragma("unroll") for (int r = 0; r < 8; ++r) { C0[r] = __builtin_amdgcn_exp2f(C0[r]); ps += C0[r]; } \
            AT_SGB4(); AT_SB(); \
            if (PV) { _Pragma("unroll") for (int dt = 0; dt < 4; ++dt) O[dt] = __builtin_amdgcn_mfma_f32_32x32x16_bf16(vB[dt], Pf[1], O[dt], 0, 0, 0); } \
            if (PV) { _Pragma("unroll") for (int dt = 0; dt < 4; ++dt) vB[dt] = *(const LAS bf16x8*)(Vs + dt * 4096 + ko[3]); } \
            if (QK) { _Pragma("unroll") for (int ks = 0; ks < 2; ++ks) { kf[2 * ks] = *(const LAS bf16x8*)(Ks + ko[ks]); kf[2 * ks + 1] = *(const LAS bf16x8*)(Ks + 4096 + ko[ks]); } } \
            _Pragma("unroll") for (int r = 8; r < 16; ++r) { C0[r] = __builtin_amdgcn_exp2f(C0[r]); ps += C0[r]; } \
            w.x = cvt_pk_bf16(C0[0], C0[1]); w.y = cvt_pk_bf16(C0[2], C0[3]); w.z = cvt_pk_bf16(C0[4], C0[5]); w.w = cvt_pk_bf16(C0[6], C0[7]); Pf[0] = __builtin_bit_cast(bf16x8, w); \
            AT_SGB4(); AT_SB(); \
            if (PV) { _Pragma("unroll") for (int dt = 0; dt < 4; ++dt) O[dt] = __builtin_amdgcn_mfma_f32_32x32x16_bf16(vA[dt], Pf[2], O[dt], 0, 0, 0); } \
            if (QK) { _Pragma("unroll") for (int ks = 2; ks < 4; ++ks) { kf[2 * ks] = *(const LAS bf16x8*)(Ks + ko[ks]); kf[2 * ks + 1] = *(const LAS bf16x8*)(Ks + 4096 + ko[ks]); } } \
            _Pragma("unroll") for (int r = 0; r < 8; ++r) { C1[r] = __builtin_amdgcn_exp2f(C1[r]); ps += C1[r]; } \
            w.x = cvt_pk_bf16(C0[8], C0[9]); w.y = cvt_pk_bf16(C0[10], C0[11]); w.z = cvt_pk_bf16(C0[12], C0[13]); w.w = cvt_pk_bf16(C0[14], C0[15]); Pf[1] = __builtin_bit_cast(bf16x8, w); \
            AT_SGB4(); AT_SB(); \
            if (PV) { _Pragma("unroll") for (int dt = 0; dt < 4; ++dt) O[dt] = __builtin_amdgcn_mfma_f32_32x32x16_bf16(vB[dt], Pf[3], O[dt], 0, 0, 0); } \
            _Pragma("unroll") for (int r = 8; r < 16; ++r) { C1[r] = __builtin_amdgcn_exp2f(C1[r]); ps += C1[r]; } \
            w.x = cvt_pk_bf16(C1[0], C1[1]); w.y = cvt_pk_bf16(C1[2], C1[3]); w.z = cvt_pk_bf16(C1[4], C1[5]); w.w = cvt_pk_bf16(C1[6], C1[7]); Pf[2] = __builtin_bit_cast(bf16x8, w); \
            AT_SGB4(); AT_SB(); \
            w.x = cvt_pk_bf16(C1[8], C1[9]); w.y = cvt_pk_bf16(C1[10], C1[11]); w.z = cvt_pk_bf16(C1[12], C1[13]); w.w = cvt_pk_bf16(C1[14], C1[15]); Pf[3] = __builtin_bit_cast(bf16x8, w); \
            l_run += ps; \
            if (QK) { const int rel_lo = ((t) + 1) * 64 - (qrow0 + 31), rel_hi = ((t) + 1) * 64 + 63 - qrow0; \
              const float cinit = (rel_lo >= 91 ? bc_pos : (rel_hi <= -91 ? bc_neg : 0.f)) - m_ref; \
              _Pragma("unroll") for (int r = 0; r < 16; ++r) { N0[r] = cinit; N1[r] = cinit; } } \
            AT_SB(); \
            if (QK) { _Pragma("unroll") for (int ks = 0; ks < 4; ++ks) { \
                N0 = __builtin_amdgcn_mfma_f32_32x32x16_bf16(kf[2 * ks], Qf[ks], N0, 0, 0, 0); \
                N1 = __builtin_amdgcn_mfma_f32_32x32x16_bf16(kf[2 * ks + 1], Qf[ks], N1, 0, 0, 0); } } \
            AT_SB(); \
        } \
          \
        __syncthreads(); \
    } while (0)
    AT_ITERX(0, Sa0, Sa1, Sb0, Sb1, 0, 1);
#pragma unroll 1
    for (int t2 = 1; t2 < 31; t2 += 2) {
        AT_ITERX(t2, Sb0, Sb1, Sa0, Sa1, 1, 1);
        AT_ITERX(t2 + 1, Sa0, Sa1, Sb0, Sb1, 1, 1);
    }
    AT_ITERX(31, Sb0, Sb1, Sa0, Sa1, 1, 0);
#undef AT_ITERX
#undef AT_SGB4
    pretail();
    {
        const LAS unsigned char* Vs = lds + AT_VS + 16384;
#pragma unroll
        for (int s2 = 0; s2 < 4; ++s2) {
            bf16x8 vf[4];
#pragma unroll
            for (int dt = 0; dt < 4; ++dt) vf[dt] = *(const LAS bf16x8*)(Vs + dt * 4096 + ko[s2]);
#pragma unroll
            for (int dt = 0; dt < 4; ++dt) O[dt] = __builtin_amdgcn_mfma_f32_32x32x16_bf16(vf[dt], Pf[s2], O[dt], 0, 0, 0);
        }
    }
    if (__all(l_run < 1e30f)) break;
    m_ref += 80.f;
    }
#undef AT_SB
#undef AT_DMA_K
#undef AT_DMA_V
    const float lt = sum_halves(l_run);
    const float inv = __builtin_amdgcn_rcpf(lt);
    if constexpr (NORM) {
#pragma unroll
    for (int dt = 0; dt < 4; ++dt)
#pragma unroll
        for (int r = 0; r < 16; ++r) O[dt][r] *= inv; }
    return inv;
}
__device__ __forceinline__ void attn_unit(const Args& a, int l, LAS unsigned char* lds, int L, const bool build_tab, float lam, float lam_init, int wave, int lane, int tid, bf16_t* Yout, const int pmode) {
    unsigned char* ws = kws();
    bf16_t* Qb = (bf16_t*)(ws + WS_Q); const bf16_t* Kb = (const bf16_t*)(ws + WS_K); const bf16_t* VT = (const bf16_t*)(ws + WS_UT); const bf16_t* ZA = (const bf16_t*)(ws + WS_ZA);
    const int x = L & 7, jj = L >> 3, bh = x + 8 * (jj >> 3), qb = jj & 7, b = bh >> 2, h = bh & 3;
    if (build_tab) {
    __syncthreads();
    { int tt = tid; asm volatile("" : "+v"(tt));
      { const int rel = tt - 256; ((LAS float*)(lds + AT_BT))[tt] = kin(I_RELB)[t5_bucket(rel) * 4 + h] * LOG2E; }
      if (tt < 128) ((LAS float*)(lds + AT_SL))[tt] = kin(I_SUBLN)[(size_t)l * 128 + tt]; }
    __syncthreads(); }
    f32x16 O[4];
    APre pre;
    (void)attn_pass<true>(lds, Qb, Kb, VT, b, h, 0, qb, wave, lane, tid, O, pmode, pre, false, [&] { attn_prefetch(pre, lds, Qb, Kb, b, h, 1, qb, wave, tid); });
    LAS unsigned* stash = (LAS unsigned*)(lds + AT_ST) + wave * 2048 + lane;
#pragma unroll
    for (int dt = 0; dt < 4; ++dt)
#pragma unroll
        for (int r = 0; r < 8; ++r) stash[(dt * 8 + r) * 64] = cvt_pk_bf16(O[dt][2 * r], O[dt][2 * r + 1]);
    u32x4 zw[8];
    const float laminv = lam * attn_pass<false>(lds, Qb, Kb, VT, b, h, 1, qb, wave, lane, tid, O, pmode, pre, true, [&] {
        int tl = tid; asm volatile("" : "+v"(tl)); const int ln = tl & 63;
        const bf16_t* zp = ZA + ((size_t)b * SEQ + qb * 256 + wave * 32 + (ln >> 4)) * 512 + h * 128 + 8 * (ln & 15);
#pragma unroll
        for (int k = 0; k < 8; ++k) zw[k] = *(const u32x4*)(zp + (size_t)k * 4 * 512); });
    float ss = 0.f;
#pragma unroll
    for (int dt = 0; dt < 4; ++dt)
#pragma unroll
        for (int r = 0; r < 8; ++r) { const unsigned p0 = stash[(dt * 8 + r) * 64]; const float o0 = bf_lo(p0) - laminv * O[dt][2 * r], o1 = bf_hi(p0) - laminv * O[dt][2 * r + 1];
            O[dt][2 * r] = o0; O[dt][2 * r + 1] = o1; ss += o0 * o0 + o1 * o1; }
    ss = sum_halves(ss);
    const float rn = __builtin_amdgcn_rsqf(ss * (1.0f / 128.0f) + 1e-5f) * __uint_as_float(__builtin_amdgcn_readfirstlane(__float_as_uint(1.0f - lam_init)));
    { int tl = tid; asm volatile("" : "+v"(tl)); lane = tl & 63; }
    const int ql = lane & 31, hi = lane >> 5;
    const LAS float* subl = (const LAS float*)(lds + AT_SL);
    LAS unsigned char* img = lds + AT_ST + wave * 8192;
#pragma unroll
    for (int dt = 0; dt < 4; ++dt)
#pragma unroll
        for (int rg = 0; rg < 4; ++rg) {
            const int dvb = 32 * dt + 8 * rg + 4 * hi;
            const f32x4 sg = *(const LAS f32x4*)(subl + dvb);
            u32x2 w; w.x = cvt_pk_bf16(O[dt][4 * rg + 0] * rn * sg[0], O[dt][4 * rg + 1] * rn * sg[1]); w.y = cvt_pk_bf16(O[dt][4 * rg + 2] * rn * sg[2], O[dt][4 * rg + 3] * rn * sg[3]);
            *(LAS u32x2*)(img + ql * 256 + ((((dvb >> 2) ^ ((ql & 7) << 1))) << 3)) = w;
        }
    { const int r0 = lane >> 4, pc = lane & 15;
      bf16_t* yp = Yout + ((size_t)b * SEQ + qb * 256 + wave * 32 + r0) * 512 + h * 128 + 8 * pc;
#pragma unroll
      for (int k = 0; k < 8; ++k) { const int r = 4 * k + r0;
          const u32x4 v = *(const LAS u32x4*)(img + r * 256 + ((pc ^ (r & 7)) << 4)); const u32x4 z = zw[k]; u32x4 o;
#define AT_GATE(V, Z) cvt_pk_bf16(bf_lo(V) * bf_lo(Z) * fast_sigmoid(bf_lo(Z)), bf_hi(V) * bf_hi(Z) * fast_sigmoid(bf_hi(Z)))
          o.x = AT_GATE(v.x, z.x); o.y = AT_GATE(v.y, z.y); o.z = AT_GATE(v.z, z.z); o.w = AT_GATE(v.w, z.w);
#undef AT_GATE
          *(u32x4*)(yp + (size_t)k * 4 * 512) = o; } }
}

constexpr int HY_FP = 8256, HY_UP = 4128;
constexpr int HY_F = 0;
constexpr int HY_U = 8 * HY_FP;
constexpr int HY_G = HY_U + 16 * HY_UP;
static_assert(HY_G + 8192 + 16 <= MISC_OFF, "hyena LDS");

__device__ __forceinline__ void conv4(const bf16_t* rowp, int t, float w0, float w1, float w2, float cb, float (&o)[4]) {
    const u32x2 mid = *(const u32x2*)(rowp + t);
    const float hm = t > 0 ? bf2f(rowp[t - 1]) : 0.f, hp = (t + 4 < SEQ) ? bf2f(rowp[t + 4]) : 0.f;
    const float h0 = bf_lo(mid.x), h1 = bf_hi(mid.x), h2 = bf_lo(mid.y), h3 = bf_hi(mid.y);
    o[0] = w0 * hm + w1 * h0 + w2 * h1 + cb; o[1] = w0 * h0 + w1 * h1 + w2 * h2 + cb; o[2] = w0 * h1 + w1 * h2 + w2 * h3 + cb; o[3] = w0 * h2 + w1 * h3 + w2 * hp + cb;
}
__device__ __forceinline__ void hy_build_copies(LAS unsigned char* lds, int tid) {
    const u32x4 A = *(const LAS u32x4*)(lds + HY_G + 16 * tid), B = *(const LAS u32x4*)(lds + HY_G + 16 * tid + 16);
    const unsigned cat[8] = {A.x, A.y, A.z, A.w, B.x, B.y, B.z, B.w};
#pragma unroll
    for (int k = 0; k < 8; ++k) { const int s = k + 1; u32x4 o;
        if ((s & 1) == 0) { o.x = cat[s / 2]; o.y = cat[s / 2 + 1]; o.z = cat[s / 2 + 2]; o.w = cat[s / 2 + 3]; }
        else { const int lo = (s - 1) / 2;
            o.x = __builtin_amdgcn_alignbit(cat[lo + 1], cat[lo], 16); o.y = __builtin_amdgcn_alignbit(cat[lo + 2], cat[lo + 1], 16);
            o.z = __builtin_amdgcn_alignbit(cat[lo + 3], cat[lo + 2], 16); o.w = __builtin_amdgcn_alignbit(cat[lo + 4], cat[lo + 3], 16); }
        *(LAS u32x4*)(lds + HY_F + k * HY_FP + 16 * tid) = o; }
}
__device__ __forceinline__ void hy_mfma(const LAS unsigned char* lds, int wave, int lane, f32x4 (&acc)[16], const int msteps) {
    const int i = lane & 15, g = lane >> 4;
    const LAS unsigned char* fb = lds + HY_F + (i & 7) * HY_FP + 2 * ((i & 8) + 8 * g) + 32 * (16 * wave);
    const LAS unsigned char* ub = lds + HY_U + i * HY_UP + 16 * g;
    bf16x8 Aw[16];
    float zf = 0.f; asm volatile("" : "+v"(zf));
#pragma unroll
    for (int tb = 0; tb < 16; ++tb) { acc[tb] = (f32x4){zf, zf, zf, zf}; Aw[tb] = *(const LAS bf16x8*)(fb + 32 * tb); }
    bf16x8 Bb[2];
    Bb[0] = *(const LAS bf16x8*)(ub);
    for (int mo = 0; mo < msteps; mo += 8) {
#pragma unroll
        for (int mi = 0; mi < 8; ++mi) {
            const int m = mo + mi;
            const bf16x8 Bf = Bb[mi & 1];
            acc[0] = __builtin_amdgcn_mfma_f32_16x16x32_bf16(Aw[(0 + 2 * mi) & 15], Bf, acc[0], 0, 0, 0);
            acc[1] = __builtin_amdgcn_mfma_f32_16x16x32_bf16(Aw[(1 + 2 * mi) & 15], Bf, acc[1], 0, 0, 0);
            __builtin_amdgcn_sched_barrier(0);
            Aw[(2 * mi) & 15] = *(const LAS bf16x8*)(fb + 32 * (16 + 2 * m));
            Aw[(2 * mi + 1) & 15] = *(const LAS bf16x8*)(fb + 32 * (17 + 2 * m));
            Bb[(mi + 1) & 1] = *(const LAS bf16x8*)(ub + 64 * (m + 1));
            __builtin_amdgcn_sched_barrier(0);
#pragma unroll
            for (int tb = 2; tb < 16; ++tb) acc[tb] = __builtin_amdgcn_mfma_f32_16x16x32_bf16(Aw[(tb + 2 * mi) & 15], Bf, acc[tb], 0, 0, 0);
            __builtin_amdgcn_sched_barrier(0);
        }
    }
}
__device__ __forceinline__ void hyena_unit(const Args& a, int l, LAS unsigned char* lds, int c, int wave, int lane, int tid, bf16_t* YTbase, const int msteps) {
    unsigned char* ws = kws();
    const bf16_t* FT = (const bf16_t*)(ws + WS_FT) + (size_t)l * (2 * 512 * 4096);
    bf16_t* UT = (bf16_t*)(ws + WS_UT);
    const bf16_t* HV = UT + (size_t)(512 + c) * MTOK; const bf16_t* HX1 = UT + (size_t)(1024 + c) * MTOK; const bf16_t* HX2 = UT + (size_t)(1536 + c) * MTOK; const bf16_t* ZH = UT + (size_t)(2048 + c) * MTOK;
    bf16_t* YT = YTbase + (size_t)c * MTOK;
    const float* cw = kin(I_CW) + (size_t)l * 3 * 1536; const float* cb = kin(I_CB) + (size_t)l * 1536;
    const float wv0 = cw[c], wv1 = cw[1536 + c], wv2 = cw[3072 + c], bv = cb[c];
    const float wa0 = cw[512 + c], wa1 = cw[1536 + 512 + c], wa2 = cw[3072 + 512 + c], ba = cb[512 + c];
    const float wb0 = cw[1024 + c], wb1 = cw[1536 + 1024 + c], wb2 = cw[3072 + 1024 + c], bb = cb[1024 + c];
    { const u32x4 ftab = *(const u32x4*)(FT + (size_t)(0 * 512 + c) * 4096 + 8 * tid);
      u32x4 hv8[8]; bf16_t he[8];
      const int ln_ = tid & 63, wq_ = (tid >> 6) & 3;
      int ie_ = ln_ < 32 ? (wq_ > 0 ? 512 * wq_ - 1 : 0) : (wq_ < 3 ? 512 * wq_ + 512 : SEQ - 1); asm volatile("" : "+v"(ie_));
#pragma unroll
      for (int it = 0; it < 8; ++it) { const int task = it * NTHR + tid, jc = task & 255, b = task >> 8; const bf16_t* rowp = HV + (size_t)b * SEQ; const int s0 = 8 * jc;
          hv8[it] = *(const u32x4*)(rowp + s0); he[it] = rowp[ie_]; }
      __syncthreads();
      *(LAS u32x4*)(lds + HY_G + 16 * tid) = ftab;
      { unsigned zz = 0u; asm volatile("" : "+v"(zz));
        if (tid == 0) *(LAS u32x4*)(lds + HY_G + 8192) = (u32x4){zz, zz, zz, zz}; }
      const int sl_ = ((ln_ + 63) & 63) << 2, sr_ = ((ln_ + 1) & 63) << 2;
#pragma unroll
      for (int it = 0; it < 8; ++it) { const int task = it * NTHR + tid, jc = task & 255, b = task >> 8; const int s0 = 8 * jc;
          const unsigned gl_ = (unsigned)__builtin_amdgcn_ds_bpermute(sl_, (int)hv8[it].w), gr_ = (unsigned)__builtin_amdgcn_ds_bpermute(sr_, (int)hv8[it].x);
          const float hev = bf2f(he[it]);
          float h[10]; h[0] = ln_ == 0 ? (wq_ > 0 ? hev : 0.f) : bf_hi(gl_); h[9] = ln_ == 63 ? (wq_ < 3 ? hev : 0.f) : bf_lo(gr_);
          h[1] = bf_lo(hv8[it].x); h[2] = bf_hi(hv8[it].x); h[3] = bf_lo(hv8[it].y); h[4] = bf_hi(hv8[it].y); h[5] = bf_lo(hv8[it].z); h[6] = bf_hi(hv8[it].z); h[7] = bf_lo(hv8[it].w); h[8] = bf_hi(hv8[it].w);
          float v[8];
#pragma unroll
          for (int e = 0; e < 8; ++e) v[e] = wv0 * h[e] + wv1 * h[e + 1] + wv2 * h[e + 2] + bv;
          u32x4 w; w.x = cvt_pk_bf16(v[7], v[6]); w.y = cvt_pk_bf16(v[5], v[4]); w.z = cvt_pk_bf16(v[3], v[2]); w.w = cvt_pk_bf16(v[1], v[0]);
          *(LAS u32x4*)(lds + HY_U + b * HY_UP + (2040 - s0) * 2) = w; } }
    __syncthreads();
    hy_build_copies(lds, tid);
    __syncthreads();
    attn_glds(FT + (size_t)(1 * 512 + c) * 4096 + 8 * tid, (unsigned)(size_t)lds + HY_G + 1024 * wave);
    f32x4 acc[16];
    const int bcol = lane & 15;
    u32x2 xm[16];
    bf16_t xe0, xe1;
    { int g4 = lane >> 4; asm volatile("" : "+v"(g4)); const bf16_t* rowp = HX1 + (size_t)bcol * SEQ;
#pragma unroll
      for (int tb = 0; tb < 16; ++tb) xm[tb] = *(const u32x2*)(rowp + 256 * wave + 16 * tb + 4 * g4);
      xe0 = rowp[wave > 0 ? 256 * wave - 1 : 0]; xe1 = rowp[wave < 7 ? 256 * wave + 256 : SEQ - 1]; }
    hy_mfma(lds, wave, lane, acc, msteps);
    asm volatile("s_waitcnt vmcnt(0)" ::: "memory");
    __syncthreads();
    hy_build_copies(lds, tid);
#define HY_HALO(tb, HM, HP) do { \
        const unsigned pl_ = (g4 == 3 && (tb) > 0) ? xm[(tb) > 0 ? (tb) - 1 : 0].y : xm[tb].y, pr_ = (g4 == 0 && (tb) < 15) ? xm[(tb) < 15 ? (tb) + 1 : 15].x : xm[tb].x; \
        const unsigned gl_ = (unsigned)__builtin_amdgcn_ds_bpermute(srcl, (int)pl_), gr_ = (unsigned)__builtin_amdgcn_ds_bpermute(srcr, (int)pr_); \
        HM = bf_hi(gl_); HP = bf_lo(gr_); \
        if ((tb) == 0) HM = g4 == 0 ? he0 : HM; \
        if ((tb) == 15) HP = g4 == 3 ? he1 : HP; } while (0)
    { int g4 = lane >> 4; asm volatile("" : "+v"(g4));
      const int srcl = (bcol + 16 * ((g4 + 3) & 3)) << 2, srcr = (bcol + 16 * ((g4 + 1) & 3)) << 2;
      const float he0 = wave > 0 ? bf2f(xe0) : 0.f, he1 = wave < 7 ? bf2f(xe1) : 0.f;
#pragma unroll
      for (int tb = 0; tb < 16; ++tb) { const int t = 256 * wave + 16 * tb + 4 * g4;
          float hm, hp; HY_HALO(tb, hm, hp);
          const float h0 = bf_lo(xm[tb].x), h1 = bf_hi(xm[tb].x), h2 = bf_lo(xm[tb].y), h3 = bf_hi(xm[tb].y);
          const float x0 = wa0 * hm + wa1 * h0 + wa2 * h1 + ba, x1 = wa0 * h0 + wa1 * h1 + wa2 * h2 + ba, x2 = wa0 * h1 + wa1 * h2 + wa2 * h3 + ba, x3 = wa0 * h2 + wa1 * h3 + wa2 * hp + ba;
          u32x2 w; w.x = cvt_pk_bf16(acc[tb][3] * x3, acc[tb][2] * x2); w.y = cvt_pk_bf16(acc[tb][1] * x1, acc[tb][0] * x0);
          *(LAS u32x2*)(lds + HY_U + bcol * HY_UP + (2044 - t) * 2) = w; } }
    __syncthreads();
#undef HY_HALO
    u32x4 x8[8], z8[8];
    { int tl = tid; asm volatile("" : "+v"(tl)); const int ln = tl & 63, hl5 = ln >> 5, p5 = ln & 31;
#pragma unroll
      for (int k = 0; k < 8; ++k) { const size_t ro = (size_t)(2 * k + hl5) * SEQ;
          x8[k] = *(const u32x4*)(HX2 + ro + 256 * wave + 8 * p5); z8[k] = *(const u32x4*)(ZH + ro + 256 * wave + 8 * p5); } }
    hy_mfma(lds, wave, lane, acc, msteps);
    bf16_t xb8[8];
    { int tl = tid; asm volatile("" : "+v"(tl)); const int ln = tl & 63, hl5 = ln >> 5, p5 = ln & 31;
      int ie = p5 < 16 ? (wave > 0 ? 256 * wave - 1 : 0) : (wave < 7 ? 256 * wave + 256 : SEQ - 1); asm volatile("" : "+v"(ie));
#pragma unroll
      for (int k = 0; k < 8; ++k) xb8[k] = HX2[(size_t)(2 * k + hl5) * SEQ + ie]; }
    __syncthreads();
    { int tl = tid; asm volatile("" : "+v"(tl)); const int ln = tl & 63, g4 = ln >> 4, bc = ln & 15, hl5 = ln >> 5, p5 = ln & 31;
      LAS unsigned char* img = lds + HY_U + 8192 * wave;
#pragma unroll
      for (int tb = 0; tb < 16; ++tb) { u32x2 w; w.x = cvt_pk_bf16(acc[tb][0], acc[tb][1]); w.y = cvt_pk_bf16(acc[tb][2], acc[tb][3]);
          *(LAS u32x2*)(img + bc * 512 + (((4 * tb + g4) ^ ((bc & 7) << 1)) << 3)) = w; }
      const int sl_ = ((ln + 63) & 63) << 2, sr_ = ((ln + 1) & 63) << 2;
      bf16_t* yp = YT + (size_t)hl5 * SEQ + 256 * wave + 8 * p5;
#pragma unroll
      for (int k = 0; k < 8; ++k) { const int row = 2 * k + hl5;
          const u32x4 yv = *(const LAS u32x4*)(img + row * 512 + ((p5 ^ (row & 7)) << 4));
          const unsigned gl_ = (unsigned)__builtin_amdgcn_ds_bpermute(sl_, (int)x8[k].w), gr_ = (unsigned)__builtin_amdgcn_ds_bpermute(sr_, (int)x8[k].x);
          const float hev = bf2f(xb8[k]);
          float h[10]; h[0] = p5 == 0 ? (wave > 0 ? hev : 0.f) : bf_hi(gl_); h[9] = p5 == 31 ? (wave < 7 ? hev : 0.f) : bf_lo(gr_);
          h[1] = bf_lo(x8[k].x); h[2] = bf_hi(x8[k].x); h[3] = bf_lo(x8[k].y); h[4] = bf_hi(x8[k].y); h[5] = bf_lo(x8[k].z); h[6] = bf_hi(x8[k].z); h[7] = bf_lo(x8[k].w); h[8] = bf_hi(x8[k].w);
          const float yr[8] = {bf_lo(yv.x), bf_hi(yv.x), bf_lo(yv.y), bf_hi(yv.y), bf_lo(yv.z), bf_hi(yv.z), bf_lo(yv.w), bf_hi(yv.w)};
          const float zz[8] = {bf_lo(z8[k].x), bf_hi(z8[k].x), bf_lo(z8[k].y), bf_hi(z8[k].y), bf_lo(z8[k].z), bf_hi(z8[k].z), bf_lo(z8[k].w), bf_hi(z8[k].w)};
          float o[8];
#pragma unroll
          for (int e = 0; e < 8; ++e) o[e] = yr[e] * (wb0 * h[e] + wb1 * h[e + 1] + wb2 * h[e + 2] + bb) * zz[e] * fast_sigmoid(zz[e]);
          u32x4 w; w.x = cvt_pk_bf16(o[0], o[1]); w.y = cvt_pk_bf16(o[2], o[3]); w.z = cvt_pk_bf16(o[4], o[5]); w.w = cvt_pk_bf16(o[6], o[7]);
          *(u32x4*)(yp + (size_t)k * 2 * SEQ) = w; } }
}

__global__ void __launch_bounds__(NTHR, 2) fwd_kernel(Args args) {
    extern __shared__ __attribute__((aligned(16))) unsigned char lds_raw[];
    LAS unsigned char* lds = (LAS unsigned char*)lds_raw;
    volatile LAS unsigned* MISC = (volatile LAS unsigned*)(lds + MISC_OFF);
    const int G = gridDim.x;
    const int wave_s = __builtin_amdgcn_readfirstlane((int)threadIdx.x >> 6);
    if (threadIdx.x < 64) MISC[threadIdx.x] = 0u;
    __syncthreads();
    const int lo = args.ph_lo, hi = args.ph_hi;
    if (hi - lo > 1) (void)xcd_barrier_post((unsigned*)(kws() + WS_CTL), MISC + 8);
#ifndef PHASE_MASK
#define PHASE_MASK 0x7f
#endif
#define EN(j) ((PHASE_MASK >> (j)) & 1)
#define IN(k) (lo <= (k) && (k) < hi)
#define SEAM(k) do { if (IN(k) && IN((k) + 1)) { XcdBarrier bl; bl.bar = (unsigned*)(kws() + WS_CTL); bl.x = xb_xcc_id(); bl.st = MISC + 8; xcd_barrier(bl); if (PROBE_DUP & 1024) xcd_barrier(bl); } } while (0)
#define PHASE_IDS() int wave = wave_s; asm volatile("" : "+s"(wave)); unsigned ones_ = ~0u; asm volatile("" : "+s"(ones_)); int tid = wave * 64 + (int)__builtin_amdgcn_mbcnt_hi(ones_, __builtin_amdgcn_mbcnt_lo(ones_, 0u)); asm volatile("" : "+v"(tid)); int bid = blockIdx.x; asm volatile("" : "+s"(bid)); const int lane = tid & 63; const int gw = bid * NWAVES + wave, NGW = G * NWAVES; (void)gw; (void)NGW; (void)lane

#define RELAUNDER() asm volatile("" : "+v"(tid))
    if (EN(0) && IN(0)) {
        PHASE_IDS();
        if (tid == 0) __hip_atomic_store((unsigned*)(kws() + WS_CTL) + XTAB_WORD0 + bid, xb_xcc_id() + 1u, __ATOMIC_RELAXED, __HIP_MEMORY_SCOPE_AGENT);
        norm_rows(args, 0, gw, MTOK, NGW, lane);
        convert_weights(args, 0, lds, gw, NGW, wave, lane);
        for (int u = bid; u < DEPTH * 64; u += G) make_filters(args, u >> 6, lds, u & 63, tid);
    }
    SEAM(0);
    for (int l = 0; l < DEPTH; ++l) {
        const int pb0 = 1 + 3 * l;
        if (EN(1) && IN(pb0 + 0)) {
            PHASE_IDS();
            __syncthreads();
            { pg8::Gemm g{(const bf16_t*)(kws() + WS_XB), (const bf16_t*)(kws() + WS_WA1), MTOK, NA1, DM}; pg8::StaticOrder S; S.init(MTOK, NA1, G, bid, (PROBE_DUP & 1) ? 2 : 1);
              pg8::EpiA1 E{(const float*)(kws() + WS_RS), (bf16_t*)(kws() + WS_Q), (bf16_t*)(kws() + WS_K), (bf16_t*)(kws() + WS_ZA), (bf16_t*)(kws() + WS_GA), (bf16_t*)(kws() + WS_GH)};
              pg8::gemm_phase<pg8::EpiA1, pg8::StaticOrder>(lds, g, S, E, tid); }
            { pg8::Gemm g{(const bf16_t*)(kws() + WS_WA2), (const bf16_t*)(kws() + WS_XB), NA2, MTOK, DM}; pg8::StaticOrder S; S.init(NA2, MTOK, G, bid, (PROBE_DUP & 2) ? 2 : 1);
              pg8::EpiA2 E{(const float*)(kws() + WS_RS), (bf16_t*)(kws() + WS_UT)};
              pg8::gemm_phase<pg8::EpiA2, pg8::StaticOrder>(lds, g, S, E, tid); }
        }
        SEAM(pb0 + 0);
        if (EN(2) && IN(pb0 + 1)) {
            PHASE_IDS();
            const float lam_init = l == 0 ? 0.2f : (l == 1 ? 0.35550906759f : (l == 2 ? 0.47071301834f : 0.55605820410f));
            const float d1 = wave_sum(kin(I_LQ1)[l * 64 + lane] * kin(I_LK1)[l * 64 + lane], lane);
            const float d2 = wave_sum(kin(I_LQ2)[l * 64 + lane] * kin(I_LK2)[l * 64 + lane], lane);
            const float lam = __uint_as_float(__builtin_amdgcn_readfirstlane(__float_as_uint(__builtin_amdgcn_exp2f(d1 * LOG2E) - __builtin_amdgcn_exp2f(d2 * LOG2E) + lam_init)));
            { constexpr int AREP = (PROBE_DUP & 4) ? 2 : 1, HREP = (PROBE_DUP & 8) ? 2 : 1;
              { int hprev = -1;
                for (int L = bid; L < 512; L += G) { const int hh = ((L & 7) + 8 * (L >> 6)) & 3; attn_unit(args, l, lds, L, hh != hprev, lam, lam_init, wave, lane, tid, (bf16_t*)(kws() + WS_Q), 0); hprev = hh; } }
              for (int c = bid; c < 512 * HREP; c += G) hyena_unit(args, l, lds, c & 511, wave, lane, tid, (c < 512 * (HREP - 1)) ? (bf16_t*)kout() : (bf16_t*)(kws() + WS_UT + (size_t)512 * MTOK * 2), (c < 512 * (HREP - 1) && (PROBE_MODE & 4)) ? 32 : 64); }
        }
        SEAM(pb0 + 1);
        if (EN(3) && IN(pb0 + 2)) {
            PHASE_IDS();
            unsigned* ctl = (unsigned*)(kws() + WS_CTL);
            pg8::StaticOrder SO; SO.init(MTOK, DM, G, bid); pg8::Unit u0; SO.next(0, u0);
            const int P0 = u0.pm, qm = u0.pn;
            const int myp = qm < 2 ? P0 : P0 + 8, myh = qm & 1;
            const size_t cset = (size_t)(l & 1) * WS_WC2;
            bool samex = true;
            const unsigned sx_ = (unsigned)__builtin_amdgcn_readfirstlane((int)MISC[12]);
            if (sx_ != 0u) samex = sx_ == 2u;
            else {
              unsigned xs[4]; const unsigned mine = xb_ld(ctl + XTAB_WORD0 + bid);
#pragma unroll
              for (int j = 0; j < 4; ++j) xs[j] = xb_ld(ctl + XTAB_WORD0 + ((bid & ~96) | (j << 5)));
#pragma unroll
              for (int j = 0; j < 4; ++j) { const int cj = (bid & ~96) | (j << 5); pg8::StaticOrder Sj; Sj.init(MTOK, DM, G, cj); pg8::Unit uj; const bool okj = Sj.next(0, uj) && uj.pm == P0;
                  samex = samex && okj && xs[j] == mine && xs[j] != 0u; }
              samex = __builtin_amdgcn_readfirstlane((int)samex) != 0;
              __syncthreads(); if (tid == 0) MISC[12] = samex ? 2u : 1u; }
            if (bid < 256) {
            { pg8::Gemm g{(const bf16_t*)(kws() + WS_Q), (const bf16_t*)(kws() + WS_WPA + cset), MTOK, DM, 512}; pg8::StaticOrder S; S.init(MTOK, DM, G, bid);
              pg8::EpiC1a E{(bf16_t*)(kws() + WS_GA), (bf16_t*)(kws() + WS_GA)};
              pg8::gemm_phase<pg8::EpiC1a, pg8::StaticOrder>(lds, g, S, E, tid); }
            RELAUNDER();
            { pg8::Gemm g{(const bf16_t*)(kws() + WS_UT + (size_t)512 * MTOK * 2), (const bf16_t*)(kws() + WS_WPH + cset), MTOK, DM, 512}; pg8::StaticOrder S; S.init(MTOK, DM, G, bid);
              pg8::EpiC1b E{(const bf16_t*)(kws() + WS_GA), (const bf16_t*)(kws() + WS_GH), (bf16_t*)(kws() + WS_GA)};
              pg8::gemm_phase<pg8::EpiC1b, pg8::StaticOrder, true, true, true>(lds, g, S, E, tid); }
            pair_post(ctl + pc_word(l, 1, P0), samex, tid);
            pair_wait(ctl, ctl + pc_word(l, 1, P0), 4u, tid);
            RELAUNDER();
            { pg8::Gemm g{(const bf16_t*)(kws() + WS_GA), (const bf16_t*)(kws() + WS_WOUT + cset), MTOK, DM, DM}; pg8::StaticOrder S; S.init(MTOK, DM, G, bid);
              pg8::EpiC2 E{(bf16_t*)(kws() + WS_GH), (float*)(kws() + WS_PART)};
              pg8::gemm_phase<pg8::EpiC2, pg8::StaticOrder>(lds, g, S, E, tid); }
            pair_post(ctl + pc_word(l, 2, P0), samex, tid);
            RELAUNDER();
            if (l + 1 < DEPTH) convert_weights(args, l + 1, lds, gw, NGW, wave, tid & 63);
            pair_wait(ctl, ctl + pc_word(l, 2, P0), 4u, tid);
            RELAUNDER();
            norm_rows(args, l + 1, myp * 256 + myh * 128 + wave, myp * 256 + myh * 128 + 128, NWAVES, tid & 63);
            } else { if (l + 1 < DEPTH) convert_weights(args, l + 1, lds, gw, NGW, wave, tid & 63); }
        }
        SEAM(pb0 + 2);
    }
#undef IN
#undef SEAM
}

#ifndef MK_PER_PHASE
#define MK_PER_PHASE 0
#endif
extern "C" void kernel_launch(void* const* d_in, const int* in_sizes, int n_in, void* d_out, int out_size, void* d_ws, size_t ws_size, hipStream_t stream) {
    static int grid = 0;
    if (grid == 0) {
        if (n_in != N_IN || out_size != MTOK * DM || ws_size < WS_END) { fprintf(stderr, "kernel_launch: unexpected shapes (n_in %d, out %d, ws %zu)\n", n_in, out_size, ws_size); grid = -1; return; }
        int dev = 0, cus = 0, per_cu = 0;
        if (hipGetDevice(&dev) != hipSuccess || hipDeviceGetAttribute(&cus, hipDeviceAttributeMultiprocessorCount, dev) != hipSuccess) { grid = -1; return; }
        if (hipFuncSetAttribute((const void*)fwd_kernel, hipFuncAttributeMaxDynamicSharedMemorySize, LDS_BYTES) != hipSuccess) { fprintf(stderr, "kernel_launch: hipFuncSetAttribute failed\n"); grid = -1; return; }
        if (hipOccupancyMaxActiveBlocksPerMultiprocessor(&per_cu, (const void*)fwd_kernel, NTHR, LDS_BYTES) != hipSuccess || per_cu < 1) fprintf(stderr, "kernel_launch: occupancy query reports %d\n", per_cu);
        (void)hipGetLastError();
        if (cus != 256) { fprintf(stderr, "kernel_launch: built for 256 CUs (row-panel pairs in phase C), found %d\n", cus); grid = -1; return; }
        grid = cus;
    }
    if (grid < 0) return;
    (void)hipMemsetAsync((char*)d_ws + WS_CTL, 0, CTL_ZERO_BYTES, stream);
    Args a{};
    for (int i = 0; i < N_IN; ++i) a.in[i] = (const float*)d_in[i];
    a.out = (float*)d_out; a.ws = (unsigned char*)d_ws;
    constexpr int NPH = 1 + 3 * DEPTH;
#if MK_PER_PHASE
    for (int p = 0; p < NPH; ++p) { a.ph_lo = p; a.ph_hi = p + 1; hipLaunchKernelGGL(fwd_kernel, dim3(grid), dim3(NTHR), LDS_BYTES, stream, a); }
#else
    a.ph_lo = 0; a.ph_hi = NPH; hipLaunchKernelGGL(fwd_kernel, dim3(grid), dim3(NTHR), LDS_BYTES, stream, a);
#endif
}
```
